# Optimizing an MI355X kernel written in HIP

```python
import jax, jax.numpy as jnp
from jax import lax
import numpy as np

D_MODEL = 2048
BATCH = 4
SEQ = 4096
DEPTH = 4

CHUNK = 64
Q_BLOCK = 128
EPS = 1e-6
NEG_INF = -1e30
ROPE_BASE = 10000.0

RET_HEADS = 8
RET_DK = 128
RET_DV = 256
RET_QK_W = RET_HEADS * RET_DK
RET_V_W = RET_HEADS * RET_DV

MLA_HEADS = 16
MLA_Q_RANK = 512
MLA_KV_RANK = 512
MLA_NOPE = 128
MLA_ROPE = 64
MLA_DV = 128
MLA_V_W = MLA_HEADS * MLA_DV

N_BRANCH = 2
IN_SPLITS = (RET_QK_W, RET_QK_W, RET_V_W, RET_V_W, MLA_Q_RANK, MLA_KV_RANK, MLA_ROPE, MLA_V_W, N_BRANCH * D_MODEL)
D_IN = 2 * RET_QK_W + 2 * RET_V_W + MLA_Q_RANK + MLA_KV_RANK + MLA_ROPE + MLA_V_W + N_BRANCH * D_MODEL

kernel_name = "hybrid_retention_mla_adaln_trunk"


def rms_norm(x, g):
    xf = x.astype(jnp.float32)
    y = xf * lax.rsqrt(jnp.mean(xf * xf, axis=-1, keepdims=True) + EPS)
    return (y * g.astype(jnp.float32)).astype(x.dtype)


def rope_tables(positions, dim):
    inv = 1.0 / (ROPE_BASE ** (jnp.arange(0, dim, 2, dtype=jnp.float32) / dim))
    ang = positions.astype(jnp.float32)[..., None] * inv
    return jnp.cos(ang), jnp.sin(ang)


def apply_rope(x, cos, sin):
    half = x.shape[-1] // 2
    x1, x2 = x[..., :half], x[..., half:]
    cos = cos.astype(x.dtype)
    sin = sin.astype(x.dtype)
    return jnp.concatenate([x1 * cos - x2 * sin, x1 * sin + x2 * cos], axis=-1)


def retention(q, k, v):
    B, S, H, dk = q.shape
    dv = v.shape[-1]
    nc = S // CHUNK
    f32 = jnp.float32
    log_gamma = jnp.log(1.0 - 2.0 ** (-5.0 - jnp.arange(H, dtype=f32)))
    qf = q.astype(f32).reshape(B, nc, CHUNK, H, dk)
    kf = (k.astype(f32) * (dk ** -0.5)).reshape(B, nc, CHUNK, H, dk)
    vf = v.astype(f32).reshape(B, nc, CHUNK, H, dv)
    idx = jnp.arange(CHUNK, dtype=f32)
    dmat = jnp.exp(jnp.abs(idx[:, None] - idx[None, :])[None] * log_gamma[:, None, None])
    scores = jnp.einsum('bnihd,bnjhd->bnhij', qf, kf) * dmat[None, None]
    o_intra = jnp.einsum('bnhij,bnjhe->bnihe', scores, vf)
    xi = jnp.exp((idx + 1.0)[:, None] * log_gamma[None, :])
    zeta = jnp.exp((CHUNK - 1.0 - idx)[:, None] * log_gamma[None, :])
    decay_chunk = jnp.exp(CHUNK * log_gamma)
    q_x = (qf * xi[None, None, :, :, None]).transpose(1, 0, 2, 3, 4)
    k_z = (kf * zeta[None, None, :, :, None]).transpose(1, 0, 2, 3, 4)
    v_t = vf.transpose(1, 0, 2, 3, 4)

    def step(state, inp):
        qc, kc, vc = inp
        o = jnp.einsum('bihd,bhde->bihe', qc, state)
        state = state * decay_chunk[None, :, None, None] + jnp.einsum('bjhd,bjhe->bhde', kc, vc)
        return state, o

    init = jnp.zeros((B, H, dk, dv), f32)
    _, o_cross = lax.scan(step, init, (q_x, k_z, v_t))
    o = o_intra + o_cross.transpose(1, 0, 2, 3, 4)
    return o.reshape(B, S, H, dv)


def head_group_norm(o):
    mu = jnp.mean(o, axis=-1, keepdims=True)
    var = jnp.mean(jnp.square(o - mu), axis=-1, keepdims=True)
    return (o - mu) * lax.rsqrt(var + EPS)


def mla_attention(q_nope, q_rope, k_nope, k_rope, v):
    B, S, H, _ = q_nope.shape
    nb = S // Q_BLOCK
    scale = (MLA_NOPE + MLA_ROPE) ** -0.5
    key_chunk = jnp.arange(S) // CHUNK

    def block(i):
        qs = i * Q_BLOCK
        qn = lax.dynamic_slice_in_dim(q_nope, qs, Q_BLOCK, axis=1)
        qr = lax.dynamic_slice_in_dim(q_rope, qs, Q_BLOCK, axis=1)
        s = (jnp.einsum('bqhd,bkhd->bhqk', qn, k_nope)
             + jnp.einsum('bqhd,bkd->bhqk', qr, k_rope)).astype(jnp.float32) * scale
        q_chunk = (qs + jnp.arange(Q_BLOCK)) // CHUNK
        mask = key_chunk[None, :] <= q_chunk[:, None]
        s = jnp.where(mask[None, None], s, NEG_INF)
        p = jax.nn.softmax(s, axis=-1)
        return jnp.einsum('bhqk,bkhd->bqhd', p.astype(v.dtype), v)

    out = lax.map(block, jnp.arange(nb))
    return out.transpose(1, 0, 2, 3, 4).reshape(B, S, H * v.shape[-1])


def hybrid_layer(x, c_act, cos_r, sin_r, cos_m, sin_m,
                 w_mod, b_mod, g_norm, w_in, g_cq, g_ckv, w_uq, w_ukv,
                 w_ret_proj, w_mla_proj, w_out):
    B, S, D = x.shape
    mod = c_act @ w_mod + b_mod
    shift, scale, gate = jnp.split(mod, 3, axis=-1)
    h = rms_norm(x, g_norm) * (1.0 + scale[:, None, :]) + shift[:, None, :]

    proj = h @ w_in
    points = np.cumsum(IN_SPLITS)[:-1].tolist()
    rq, rk, rv, rg, cq, ckv, kr, mg, bg = jnp.split(proj, points, axis=-1)

    rq = apply_rope(rq.reshape(B, S, RET_HEADS, RET_DK), cos_r[:, :, None], sin_r[:, :, None])
    rk = apply_rope(rk.reshape(B, S, RET_HEADS, RET_DK), cos_r[:, :, None], sin_r[:, :, None])
    rv = rv.reshape(B, S, RET_HEADS, RET_DV)
    o_ret = head_group_norm(retention(rq, rk, rv)).reshape(B, S, RET_V_W).astype(x.dtype)
    y_ret = (o_ret * jax.nn.silu(rg)) @ w_ret_proj

    q = (rms_norm(cq, g_cq) @ w_uq).reshape(B, S, MLA_HEADS, MLA_NOPE + MLA_ROPE)
    q_nope, q_rope = q[..., :MLA_NOPE], q[..., MLA_NOPE:]
    q_rope = apply_rope(q_rope, cos_m[:, :, None], sin_m[:, :, None])
    kv = (rms_norm(ckv, g_ckv) @ w_ukv).reshape(B, S, MLA_HEADS, MLA_NOPE + MLA_DV)
    k_nope, v = kv[..., :MLA_NOPE], kv[..., MLA_NOPE:]
    k_rope = apply_rope(kr, cos_m, sin_m)
    o_mla = mla_attention(q_nope, q_rope, k_nope, k_rope, v)
    y_mla = (o_mla * jax.nn.silu(mg)) @ w_mla_proj

    g_a, g_b = jnp.split(jax.nn.sigmoid(bg), 2, axis=-1)
    merged = g_a * y_ret + g_b * y_mla
    out = merged @ w_out
    return x + gate[:, None, :] * out


def setup_inputs(seed: int = 0) -> dict:
    key = jax.random.key(seed)
    ks = jax.random.split(key, 16)
    f32 = jnp.float32

    def nrm(k, shape, fan_in, mult=1.0):
        return jax.random.normal(k, shape, f32) * (mult * fan_in ** -0.5)

    x = jax.random.normal(ks[0], (BATCH, SEQ, D_MODEL), f32)
    c = jax.random.normal(ks[1], (BATCH, D_MODEL), f32)
    positions = (jnp.arange(SEQ, dtype=jnp.int32)[None, :]
                 + jax.random.randint(ks[2], (BATCH, 1), 0, 1024, dtype=jnp.int32))
    w_mod = nrm(ks[3], (DEPTH, D_MODEL, 3 * D_MODEL), D_MODEL, 0.5)
    b_mod = 0.01 * jax.random.normal(ks[4], (DEPTH, 3 * D_MODEL), f32)
    g_norm = 1.0 + 0.02 * jax.random.normal(ks[5], (DEPTH, D_MODEL), f32)
    w_in = nrm(ks[6], (DEPTH, D_MODEL, D_IN), D_MODEL)
    g_cq = 1.0 + 0.02 * jax.random.normal(ks[7], (DEPTH, MLA_Q_RANK), f32)
    g_ckv = 1.0 + 0.02 * jax.random.normal(ks[8], (DEPTH, MLA_KV_RANK), f32)
    w_uq = nrm(ks[9], (DEPTH, MLA_Q_RANK, MLA_HEADS * (MLA_NOPE + MLA_ROPE)), MLA_Q_RANK)
    w_ukv = nrm(ks[10], (DEPTH, MLA_KV_RANK, MLA_HEADS * (MLA_NOPE + MLA_DV)), MLA_KV_RANK)
    w_ret_proj = nrm(ks[11], (DEPTH, RET_V_W, D_MODEL), RET_V_W)
    w_mla_proj = nrm(ks[12], (DEPTH, MLA_V_W, D_MODEL), MLA_V_W)
    w_out = nrm(ks[13], (DEPTH, D_MODEL, D_MODEL), D_MODEL)
    g_final = 1.0 + 0.02 * jax.random.normal(ks[14], (D_MODEL,), f32)
    return {"x": x, "c": c, "positions": positions, "w_mod": w_mod, "b_mod": b_mod,
            "g_norm": g_norm, "w_in": w_in, "g_cq": g_cq, "g_ckv": g_ckv, "w_uq": w_uq,
            "w_ukv": w_ukv, "w_ret_proj": w_ret_proj, "w_mla_proj": w_mla_proj,
            "w_out": w_out, "g_final": g_final}


def reference(x, c, positions, w_mod, b_mod, g_norm, w_in, g_cq, g_ckv, w_uq, w_ukv,
              w_ret_proj, w_mla_proj, w_out, g_final):
    c_act = jax.nn.silu(c)
    cos_r, sin_r = rope_tables(positions, RET_DK)
    cos_m, sin_m = rope_tables(positions, MLA_ROPE)
    for l in range(DEPTH):
        x = hybrid_layer(x, c_act, cos_r, sin_r, cos_m, sin_m,
                         w_mod[l], b_mod[l], g_norm[l], w_in[l], g_cq[l], g_ckv[l],
                         w_uq[l], w_ukv[l], w_ret_proj[l], w_mla_proj[l], w_out[l])
    return rms_norm(x, g_final)
```

```cpp
#include <hip/hip_runtime.h>
#include <hip/hip_cooperative_groups.h>
#include <cstdio>
#include <cmath>
#include <cstdint>
namespace cg = cooperative_groups;

#ifndef MK_COOP
#define MK_COOP 1
#endif

constexpr int T_TOK = 16384, DM = 2048, NBATCH = 4, SEQ = 4096, DEPTH = 4;
constexpr int DIN = 13376, DINP = 13568;
constexpr int NQ = 3072, NKV = 4096;
constexpr float EPS = 1e-6f;
constexpr int NTHREADS = 512;
constexpr int LDS_BYTES = 131072;

typedef unsigned short bf16_t;
typedef short bf16x8 __attribute__((ext_vector_type(8)));
typedef short s16x4 __attribute__((ext_vector_type(4)));
typedef float f32x4 __attribute__((ext_vector_type(4)));
typedef float f32x2 __attribute__((ext_vector_type(2)));
typedef float f32x16 __attribute__((ext_vector_type(16)));
typedef unsigned u32x4 __attribute__((ext_vector_type(4)));
typedef unsigned u32x2 __attribute__((ext_vector_type(2)));

typedef __bf16 bf16x2_t __attribute__((ext_vector_type(2)));
__device__ __forceinline__ unsigned cvt_pk_bf16(float lo, float hi) { f32x2 v = {lo, hi}; bf16x2_t r = __builtin_convertvector(v, bf16x2_t); return __builtin_bit_cast(unsigned, r); }
__device__ __forceinline__ int tid_opaque() { int t = threadIdx.x; asm volatile("" : "+v"(t)); return t; }
__device__ __forceinline__ int lane_opaque() { int l; asm volatile("v_mbcnt_lo_u32_b32 %0, -1, 0\n\tv_mbcnt_hi_u32_b32 %0, -1, %0" : "=v"(l)); return l; }
__device__ __forceinline__ float xadd32(float x) { auto r = __builtin_amdgcn_permlane32_swap(__float_as_uint(x), __float_as_uint(x), false, false); return __uint_as_float(r[0]) + __uint_as_float(r[1]); }
__device__ __forceinline__ float xadd16(float x) { auto r = __builtin_amdgcn_permlane16_swap(__float_as_uint(x), __float_as_uint(x), false, false); return __uint_as_float(r[0]) + __uint_as_float(r[1]); }
__device__ __forceinline__ float bf_lo(unsigned w) { return __uint_as_float(w << 16); }
__device__ __forceinline__ float bf_hi(unsigned w) { return __uint_as_float(w & 0xffff0000u); }
__device__ __forceinline__ float bf2f(bf16_t v) { return __uint_as_float(((unsigned)v) << 16); }
__device__ __forceinline__ bf16_t f2bf(float f) { return (bf16_t)(cvt_pk_bf16(f, 0.f) & 0xffffu); }
__device__ __forceinline__ float silu_f(float x) { return x * __builtin_amdgcn_rcpf(1.0f + __expf(-x)); }
__device__ __forceinline__ float sigmoid_f(float x) { return __builtin_amdgcn_rcpf(1.0f + __expf(-x)); }

constexpr size_t al256(size_t x) { return (x + 255) / 256 * 256; }
constexpr size_t SZ_WT_IN = (size_t)DINP * DM * 2, SZ_WT_Q = (size_t)NQ * 512 * 2, SZ_WT_KV = (size_t)NKV * 512 * 2, SZ_WT_RM = (size_t)DM * 4096 * 2, SZ_WT_O = (size_t)DM * DM * 2;
constexpr size_t WS_WT_IN = 0;
constexpr size_t WS_WT_Q = WS_WT_IN + DEPTH * SZ_WT_IN;
constexpr size_t WS_WT_KV = WS_WT_Q + DEPTH * SZ_WT_Q;
constexpr size_t WS_WT_RM = WS_WT_KV + DEPTH * SZ_WT_KV;
constexpr size_t WS_WT_O = WS_WT_RM + DEPTH * SZ_WT_RM;
constexpr size_t WS_MOD = WS_WT_O + DEPTH * SZ_WT_O;
constexpr size_t WS_BIAS2 = WS_MOD + al256((size_t)DEPTH * 4 * 6144 * 4);
constexpr size_t WS_COSR = WS_BIAS2 + al256((size_t)DEPTH * 4 * DINP * 4);
constexpr size_t WS_SINR = WS_COSR + (size_t)T_TOK * 64 * 4;
constexpr size_t WS_COSM = WS_SINR + (size_t)T_TOK * 64 * 4;
constexpr size_t WS_SINM = WS_COSM + (size_t)T_TOK * 32 * 4;
constexpr size_t WS_SSQX = WS_SINM + (size_t)T_TOK * 32 * 4;
constexpr size_t WS_SSQC = WS_SSQX + (size_t)T_TOK * 32 * 4;
constexpr size_t WS_XG = WS_SSQC + (size_t)T_TOK * 16 * 4;
constexpr size_t WS_RQ = WS_XG + (size_t)T_TOK * 2048 * 2;
constexpr size_t WS_RK = WS_RQ + (size_t)T_TOK * 1024 * 2;
constexpr size_t WS_RV = WS_RK + (size_t)T_TOK * 1024 * 2;
constexpr size_t WS_SRG = WS_RV + (size_t)T_TOK * 2048 * 2;
constexpr size_t WS_SMG = WS_SRG + (size_t)T_TOK * 2048 * 2;
constexpr size_t WS_CQ = WS_SMG + (size_t)T_TOK * 2048 * 2;
constexpr size_t WS_CKV = WS_CQ + (size_t)T_TOK * 512 * 2;
constexpr size_t WS_GATE = WS_CKV + (size_t)T_TOK * 512 * 2;
constexpr size_t WS_QB = WS_GATE + (size_t)T_TOK * 4096 * 2;
constexpr size_t WS_KB = WS_QB + (size_t)T_TOK * 3072 * 2;
constexpr size_t WS_VB = WS_KB + (size_t)T_TOK * 3072 * 2;
constexpr size_t WS_AR = WS_VB + (size_t)T_TOK * 2048 * 2;
#if defined(MK_DEBUG)
constexpr size_t WS_MERGED = WS_AR + (size_t)T_TOK * 4096 * 2;
constexpr size_t WS_END = WS_MERGED + (size_t)T_TOK * 2048 * 2;
#else
constexpr size_t WS_MERGED = WS_RQ;
constexpr size_t WS_END = WS_AR + (size_t)T_TOK * 4096 * 2;
#endif

struct Params {
    const float* x; const float* c; const int* pos; const float* w_mod; const float* b_mod; const float* g_norm; const float* w_in; const float* g_cq; const float* g_ckv;
    const float* w_uq; const float* w_ukv; const float* w_ret; const float* w_mla; const float* w_out; const float* g_final;
    float* out; unsigned char* ws; int ph_lo, ph_hi;
    float inv_r[64]; float inv_m[32];
};

namespace pg8 {
#define PG8_LAS __attribute__((address_space(3)))
constexpr int BM = 256, BK = 64, HALF = 128, HTB = HALF * BK * 2  , STAGE_BYTES = 8 * HTB, NXCD = 8, WGM = 8;
__host__ __device__ __forceinline__ int lds_byte(int r, int c) { const int st = (r >> 4) * 2 + (c >> 5), rr = r & 15, cc = c & 31, ob = rr * 64 + cc * 2; return st * 1024 + (ob ^ (((ob >> 9) & 1) << 5)); }
__host__ __device__ __forceinline__ void stage_rc(int b, int& R, int& C) { const int st = b / 1024, sb = b % 1024, swz = sb ^ (((sb >> 9) & 1) << 5); R = (st >> 1) * 16 + swz / 64; C = (st & 1) * 32 + (swz % 64) / 2; }
__host__ __device__ __forceinline__ int perm32(int rho) { const int n = rho >> 4, i = rho & 15; return 8 * (i >> 2) + 4 * n + (i & 3); }

struct Unit { int pm, pn; };
struct Gemm { const bf16_t* A; const bf16_t* Bt; int M, N, K; };

struct StaticOrder {
    int nM, nN, nwg, G, c;
    __host__ __device__ void init(int M, int N, int G_, int c_) { nM = M / BM; nN = N / BM; nwg = nM * nN; G = G_; c = c_; }
    __host__ __device__ bool next(int i, Unit& u) const {
        const long L = (long)i * G + c; if (L >= nwg) return false;
        int wgid = (int)L; { const int q = nwg / NXCD, r = nwg % NXCD, xcd = wgid % NXCD, off = wgid / NXCD; wgid = (xcd < r ? xcd * (q + 1) : r * (q + 1) + (xcd - r) * q) + off; }
        const int nig = WGM * nN, gid = wgid / nig, fm = gid * WGM, gsz = (nM - fm) < WGM ? (nM - fm) : WGM;
        u.pm = fm + ((wgid % nig) % gsz); u.pn = (wgid % nig) / gsz; return true;
    }
    __device__ __forceinline__ void a_ready(const Unit&) const {}
    __device__ __forceinline__ void done(const Unit&) const {}
};

template <class Epi, class Sched>
__device__ __forceinline__ void gemm_phase(PG8_LAS unsigned char* lds, const Gemm g, const Sched& S, const Epi& E) {
    const int tid = tid_opaque(), wid = __builtin_amdgcn_readfirstlane(tid >> 6), lane = tid & 63, wr = wid >> 2, wc = wid & 3, fr = lane & 15, fq = lane >> 4;
    const int K = g.K, nt = K / BK;
    unsigned voffA[2], voffB[2];
#pragma unroll
    for (int i = 0; i < 2; ++i) { int R, C; stage_rc(tid * 16 + i * 8192, R, C); const int Rb = Epi::PERM ? ((R & ~31) + perm32(R & 31)) : R;
        voffA[i] = (unsigned)(R * K + C) * 2u; voffB[i] = (unsigned)(Rb * K + C) * 2u; }
    const size_t kstep = (size_t)(BK * 2);
    const size_t hstep = (size_t)HALF * K * 2;
    const size_t tstep = 2 * hstep;
    const unsigned ldsw = (unsigned)wid * 1024u;
    const int aoff = lds_byte(wr * 64 + fr, fq * 8), boff = lds_byte(wc * 32 + fr, fq * 8);
#define PG8_SA(b, h) (((b) * 2 + (h)) * HTB)
#define PG8_SB(b, h) ((4 + (b) * 2 + (h)) * HTB)
#define PG8_STAGE(bufoff, gbase, voff) do { _Pragma("unroll") for (int _i = 0; _i < 2; ++_i) \
        __builtin_amdgcn_global_load_lds((const unsigned*)((const char*)(gbase) + (voff)[_i]), (PG8_LAS unsigned*)(lds + (bufoff) + ldsw + _i * 8192), 16, 0, 0); } while (0)
#define PG8_LDA(dst, b, h) do { _Pragma("unroll") for (int m = 0; m < 4; ++m) _Pragma("unroll") for (int k = 0; k < 2; ++k) dst[m][k] = *(const PG8_LAS bf16x8*)(lds + PG8_SA(b, h) + aoff + m * 2048 + k * 1024); } while (0)
#define PG8_LDB(dst, b, h) do { _Pragma("unroll") for (int n = 0; n < 2; ++n) _Pragma("unroll") for (int k = 0; k < 2; ++k) dst[n][k] = *(const PG8_LAS bf16x8*)(lds + PG8_SB(b, h) + boff + n * 2048 + k * 1024); } while (0)
#define PG8_MMA(ai, bj, At, Bt) do { __builtin_amdgcn_s_setprio(1); _Pragma("unroll") for (int m = 0; m < 4; ++m) _Pragma("unroll") for (int n = 0; n < 2; ++n) _Pragma("unroll") for (int k = 0; k < 2; ++k) \
        acc[ai][bj][m][n] = __builtin_amdgcn_mfma_f32_16x16x32_bf16(Bt[n][k], At[m][k], acc[ai][bj][m][n], 0, 0, 0); __builtin_amdgcn_s_setprio(0); } while (0)
#define PG8_WAIT_V(n) asm volatile("s_waitcnt vmcnt(" #n ")" ::: "memory")
#define PG8_WAIT_L(n) asm volatile("s_waitcnt lgkmcnt(" #n ")" ::: "memory")
#define PG8_BAR __builtin_amdgcn_s_barrier()
#define PG8_SCHED __builtin_amdgcn_sched_barrier(0)
    Unit cur, nxt; int ui = 0;
    if (!S.next(0, cur)) return;
    f32x4 acc[2][2][4][2];
#pragma unroll
    for (int a = 0; a < 2; ++a)
#pragma unroll
        for (int b = 0; b < 2; ++b)
#pragma unroll
            for (int m = 0; m < 4; ++m)
#pragma unroll
                for (int n = 0; n < 2; ++n) acc[a][b][m][n] = (f32x4){0.f, 0.f, 0.f, 0.f};
    bf16x8 At[4][2], B0[2][2], B1[2][2];
    const char* cA = (const char*)g.A + (size_t)cur.pm * tstep; const char* cB = (const char*)g.Bt + (size_t)cur.pn * tstep;
    S.a_ready(cur);
    PG8_STAGE(PG8_SB(0, 0), cB, voffB); PG8_STAGE(PG8_SA(0, 0), cA, voffA); PG8_STAGE(PG8_SB(0, 1), cB + hstep, voffB); PG8_STAGE(PG8_SA(0, 1), cA + hstep, voffA);
    if (wr == 1) PG8_BAR;
    PG8_WAIT_V(4); PG8_BAR;
    PG8_STAGE(PG8_SB(1, 0), cB + kstep, voffB); PG8_STAGE(PG8_SA(1, 0), cA + kstep, voffA); PG8_STAGE(PG8_SB(1, 1), cB + hstep + kstep, voffB);
    PG8_WAIT_V(6); PG8_BAR;
    for (;;) {
        const bool has_next = S.next(ui + 1, nxt);
        const char* nA = has_next ? (const char*)g.A + (size_t)nxt.pm * tstep : cA; const char* nB = has_next ? (const char*)g.Bt + (size_t)nxt.pn * tstep : cB;
        for (int t = 0; t < nt; t += 2) {
            const bool last = (t == nt - 2);
            const char* a1 = cA + (size_t)(t + 1) * kstep;
            const char* a2 = last ? nA : cA + (size_t)(t + 2) * kstep; const char* b2 = last ? nB : cB + (size_t)(t + 2) * kstep;
            const char* a3 = a2 + kstep; const char* b3 = b2 + kstep;
            if constexpr (Epi::HAS_MID) { if (t == (nt >> 1)) E.mid(acc, cur, wr, wc, fr, fq); }
            if (last && has_next) S.a_ready(nxt);
            PG8_LDB(B0, 0, 0); PG8_SCHED; PG8_LDA(At, 0, 0); PG8_STAGE(PG8_SA(1, 1), a1 + hstep, voffA);
            PG8_WAIT_L(8); PG8_BAR; PG8_WAIT_L(0); PG8_MMA(0, 0, At, B0); PG8_BAR; PG8_SCHED;
            PG8_LDB(B1, 0, 1); PG8_STAGE(PG8_SB(0, 0), b2, voffB);
            PG8_BAR; PG8_WAIT_L(0); PG8_MMA(0, 1, At, B1); PG8_BAR;
            PG8_LDA(At, 0, 1); PG8_STAGE(PG8_SA(0, 0), a2, voffA);
            PG8_BAR; PG8_WAIT_L(0); PG8_MMA(1, 0, At, B0); PG8_BAR; PG8_SCHED;
            PG8_STAGE(PG8_SB(0, 1), b2 + hstep, voffB);
            PG8_WAIT_V(6); PG8_BAR; PG8_MMA(1, 1, At, B1); PG8_BAR;
            PG8_LDB(B0, 1, 0); PG8_SCHED; PG8_LDA(At, 1, 0); PG8_STAGE(PG8_SA(0, 1), a2 + hstep, voffA);
            PG8_WAIT_L(8); PG8_BAR; PG8_WAIT_L(0); PG8_MMA(0, 0, At, B0); PG8_BAR; PG8_SCHED;
            PG8_LDB(B1, 1, 1); PG8_STAGE(PG8_SB(1, 0), b3, voffB);
            PG8_BAR; PG8_WAIT_L(0); PG8_MMA(0, 1, At, B1); PG8_BAR;
            PG8_LDA(At, 1, 1); PG8_STAGE(PG8_SA(1, 0), a3, voffA);
            PG8_BAR; PG8_WAIT_L(0); PG8_MMA(1, 0, At, B0); PG8_BAR; PG8_SCHED;
            PG8_STAGE(PG8_SB(1, 1), b3 + hstep, voffB);
            PG8_WAIT_V(6); PG8_BAR; PG8_MMA(1, 1, At, B1); PG8_BAR;
        }
        E(acc, cur, wr, wc, fr, fq); S.done(cur);
        if (!has_next) break;
#pragma unroll
        for (int a = 0; a < 2; ++a)
#pragma unroll
            for (int b = 0; b < 2; ++b)
#pragma unroll
                for (int m = 0; m < 4; ++m)
#pragma unroll
                    for (int n = 0; n < 2; ++n) acc[a][b][m][n] = (f32x4){0.f, 0.f, 0.f, 0.f};
        cur = nxt; cA = nA; cB = nB; ++ui;
    }
    PG8_WAIT_V(0);
    if (wr == 0) PG8_BAR;
    PG8_BAR;
#undef PG8_SA
#undef PG8_SB
#undef PG8_STAGE
#undef PG8_LDA
#undef PG8_LDB
#undef PG8_MMA
#undef PG8_WAIT_V
#undef PG8_WAIT_L
#undef PG8_BAR
#undef PG8_SCHED
}
}

using pg8::Unit;
typedef const f32x4 (&AccC)[2][2][4][2];
typedef f32x4 (&AccM)[2][2][4][2];

__device__ __forceinline__ void st8(bf16_t* p, const float (&v)[8]) {
    u32x4 w; w.x = cvt_pk_bf16(v[0], v[1]); w.y = cvt_pk_bf16(v[2], v[3]); w.z = cvt_pk_bf16(v[4], v[5]); w.w = cvt_pk_bf16(v[6], v[7]); *(u32x4*)p = w;
}
__device__ __forceinline__ void rope8(float (&v)[8], const float* cp, const float* sp) {
    const f32x4 c = *(const f32x4*)cp, s = *(const f32x4*)sp;
#pragma unroll
    for (int q = 0; q < 4; ++q) { const float x1 = v[2 * q], x2 = v[2 * q + 1]; v[2 * q] = x1 * c[q] - x2 * s[q]; v[2 * q + 1] = x1 * s[q] + x2 * c[q]; }
}

struct EpiIn {
    static constexpr bool PERM = true, HAS_MID = false;
    const float* ssqx; const float* bias2; const float* cos_r; const float* sin_r; const float* cos_m; const float* sin_m;
    bf16_t *RQ, *RK, *RV, *SRG, *CQ, *CKV, *SMG, *GATE, *KB; float* ssqc;
    __device__ __forceinline__ void mid(AccM, const Unit&, int, int, int, int) const {}
    template <int MODE> __device__ __forceinline__ void body(AccC acc, const Unit& u, int wr, int wc, int fr, int fq) const {
        const int pn = u.pn, row0 = u.pm * 256 + wr * 64 + fr, b = u.pm >> 4, cl = wc * 32 + 8 * fq;
        float rinv[2][4];
#pragma unroll
        for (int ai = 0; ai < 2; ++ai)
#pragma unroll
            for (int m = 0; m < 4; ++m) { const float* sp = ssqx + (size_t)(row0 + ai * 128 + m * 16) * 32 + fq * 8; const f32x4 a = *(const f32x4*)sp, c = *(const f32x4*)(sp + 4);
                float s = ((a[0] + a[1]) + (a[2] + a[3])) + ((c[0] + c[1]) + (c[2] + c[3])); s = xadd16(s); s = xadd32(s); rinv[ai][m] = rsqrtf(s * (1.0f / 2048.0f) + EPS); }
        f32x4 bz[2][2];
#pragma unroll
        for (int bj = 0; bj < 2; ++bj) { const float* bp = bias2 + (size_t)b * DINP + pn * 256 + bj * 128 + cl; bz[bj][0] = *(const f32x4*)bp; bz[bj][1] = *(const f32x4*)(bp + 4); }
#pragma unroll
        for (int ai = 0; ai < 2; ++ai)
#pragma unroll
            for (int m = 0; m < 4; ++m) {
                const int row = row0 + ai * 128 + m * 16; const float r = rinv[ai][m];
                float ssq = 0.f;
#pragma unroll
                for (int bj = 0; bj < 2; ++bj) {
                    if (MODE == 5 && (bj != 0 || wc >= 2)) continue;
                    const int col = pn * 256 + bj * 128 + cl;
                    const f32x4 a0 = acc[ai][bj][m][0] * r + bz[bj][0], a1 = acc[ai][bj][m][1] * r + bz[bj][1];
                    float v[8] = {a0[0], a0[1], a0[2], a0[3], a1[0], a1[1], a1[2], a1[3]};
                    if (MODE == 0) {
                        rope8(v, cos_r + (size_t)row * 64 + (cl >> 1), sin_r + (size_t)row * 64 + (cl >> 1));
                        if (pn >= 4) {
#pragma unroll
                            for (int i = 0; i < 8; ++i) v[i] *= 0.08838834764831845f;
                        }
                        bf16_t* dst = (pn < 4 ? RQ : RK) + (size_t)row * 1024 + (pn & 3) * 256 + bj * 128 + cl; st8(dst, v);
                    } else if (MODE == 1) {
                        st8(RV + (size_t)row * 2048 + (col - 2048), v);
                    } else if (MODE == 2) {
#pragma unroll
                        for (int i = 0; i < 8; ++i) v[i] = silu_f(v[i]);
                        bf16_t* dst = (pn < 24) ? SRG + (size_t)row * 2048 + (col - 4096) : SMG + (size_t)row * 2048 + (col - 7168); st8(dst, v);
                    } else if (MODE == 3) {
#pragma unroll
                        for (int i = 0; i < 8; ++i) v[i] = sigmoid_f(v[i]);
                        st8(GATE + (size_t)row * 4096 + (col - 9216), v);
                    } else if (MODE == 4) {
#pragma unroll
                        for (int i = 0; i < 8; ++i) ssq += v[i] * v[i];
                        asm volatile("" : "+v"(ssq));
                        bf16_t* dst = (pn < 26) ? CQ + (size_t)row * 512 + (col - 6144) : CKV + (size_t)row * 512 + (col - 6656); st8(dst, v);
                    } else {
                        rope8(v, cos_m + (size_t)row * 32 + (cl >> 1), sin_m + (size_t)row * 32 + (cl >> 1));
                        bf16_t* dst = KB + (size_t)row * 3072 + 128 + cl;
                        u32x4 w; w.x = cvt_pk_bf16(v[0], v[1]); w.y = cvt_pk_bf16(v[2], v[3]); w.z = cvt_pk_bf16(v[4], v[5]); w.w = cvt_pk_bf16(v[6], v[7]);
#pragma unroll 1
                        for (int h = 0; h < 16; ++h) { *(u32x4*)dst = w; dst += 192; }
                    }
                }
                if (MODE == 4) { ssq = xadd16(ssq); ssq = xadd32(ssq); if (fq == 0) ssqc[(size_t)row * 16 + (pn - 24) * 4 + wc] = ssq; }
                asm volatile("" ::: "memory");
            }
    }
    __device__ __forceinline__ void operator()(AccC acc, const Unit& u, int wr, int wc, int fr, int fq) const {
        { const int l_ = lane_opaque(); fr = l_ & 15; fq = l_ >> 4; }
        const int pn = u.pn;
        if (pn < 8) body<0>(acc, u, wr, wc, fr, fq);
        else if (pn < 16) body<1>(acc, u, wr, wc, fr, fq);
        else if (pn < 24) body<2>(acc, u, wr, wc, fr, fq);
        else if (pn < 28) body<4>(acc, u, wr, wc, fr, fq);
        else if (pn < 36) body<2>(acc, u, wr, wc, fr, fq);
        else if (pn < 52) body<3>(acc, u, wr, wc, fr, fq);
        else body<5>(acc, u, wr, wc, fr, fq);
    }
};

template <int KV> struct EpiUp {
    static constexpr bool PERM = true, HAS_MID = false;
    const float* ssqc; const float* cos_m; const float* sin_m; bf16_t* QB; bf16_t* KB; bf16_t* VB;
    __device__ __forceinline__ void mid(AccM, const Unit&, int, int, int, int) const {}
    __device__ __forceinline__ void operator()(AccC acc, const Unit& u, int wr, int wc, int fr, int fq) const {
        { const int l_ = lane_opaque(); fr = l_ & 15; fq = l_ >> 4; }
        const int pn = u.pn, row0 = u.pm * 256 + wr * 64 + fr, cl = wc * 32 + 8 * fq;
        float rinv[2][4];
#pragma unroll
        for (int ai = 0; ai < 2; ++ai)
#pragma unroll
            for (int m = 0; m < 4; ++m) { const float* sp = ssqc + (size_t)(row0 + ai * 128 + m * 16) * 16 + KV * 8; const f32x4 a = *(const f32x4*)sp, c = *(const f32x4*)(sp + 4);
                const float s = ((a[0] + a[1]) + (a[2] + a[3])) + ((c[0] + c[1]) + (c[2] + c[3])); rinv[ai][m] = rsqrtf(s * (1.0f / 512.0f) + EPS); }
#pragma unroll
        for (int bj = 0; bj < 2; ++bj)
#pragma unroll
            for (int ai = 0; ai < 2; ++ai)
#pragma unroll
                for (int m = 0; m < 4; ++m) {
                    const int row = row0 + ai * 128 + m * 16; const float r = rinv[ai][m];
                    const f32x4 a0 = acc[ai][bj][m][0] * r, a1 = acc[ai][bj][m][1] * r;
                    float v[8] = {a0[0], a0[1], a0[2], a0[3], a1[0], a1[1], a1[2], a1[3]};
                    if (KV == 0) {
                        if (pn < 8) { st8(QB + (size_t)row * 3072 + (pn * 2 + bj) * 192 + cl, v); }
                        else { const int rr = (pn - 8) * 256 + bj * 128 + cl, h = rr >> 6, p = rr & 63;
                            rope8(v, cos_m + (size_t)row * 32 + (p >> 1), sin_m + (size_t)row * 32 + (p >> 1));
                            st8(QB + (size_t)row * 3072 + h * 192 + 128 + p, v); }
                    } else {
                        if (pn < 8) st8(KB + (size_t)row * 3072 + (pn * 2 + bj) * 192 + cl, v);
                        else st8(VB + (size_t)row * 2048 + (pn - 8) * 256 + bj * 128 + cl, v);
                    }
                    asm volatile("" ::: "memory");
                }
    }
};

struct EpiMerge {
    static constexpr bool PERM = true, HAS_MID = true;
    const bf16_t* GATE; bf16_t* MERGED;
    __device__ __forceinline__ void mid(AccM acc, const Unit& u, int wr, int wc, int fr, int fq) const {
        { const int l_ = lane_opaque(); fr = l_ & 15; fq = l_ >> 4; }
        const int row0 = u.pm * 256 + wr * 64 + fr, cl = wc * 32 + 8 * fq;
#pragma unroll
        for (int ai = 0; ai < 2; ++ai)
#pragma unroll
            for (int m = 0; m < 4; ++m) {
#pragma unroll
                for (int bj = 0; bj < 2; ++bj) {
                    const bf16_t* gp = GATE + (size_t)(row0 + ai * 128 + m * 16) * 4096 + u.pn * 256 + bj * 128 + cl;
                    const u32x4 ga = *(const u32x4*)gp, gb = *(const u32x4*)(gp + 2048);
                    f32x4 r0, r1;
                    r0[0] = bf_lo(ga.x) * __builtin_amdgcn_rcpf(bf_lo(gb.x)); r0[1] = bf_hi(ga.x) * __builtin_amdgcn_rcpf(bf_hi(gb.x));
                    r0[2] = bf_lo(ga.y) * __builtin_amdgcn_rcpf(bf_lo(gb.y)); r0[3] = bf_hi(ga.y) * __builtin_amdgcn_rcpf(bf_hi(gb.y));
                    r1[0] = bf_lo(ga.z) * __builtin_amdgcn_rcpf(bf_lo(gb.z)); r1[1] = bf_hi(ga.z) * __builtin_amdgcn_rcpf(bf_hi(gb.z));
                    r1[2] = bf_lo(ga.w) * __builtin_amdgcn_rcpf(bf_lo(gb.w)); r1[3] = bf_hi(ga.w) * __builtin_amdgcn_rcpf(bf_hi(gb.w));
                    acc[ai][bj][m][0] *= r0; acc[ai][bj][m][1] *= r1;
                    asm volatile("" ::: "memory");
                }
            }
    }
    __device__ __forceinline__ void operator()(AccC acc, const Unit& u, int wr, int wc, int fr, int fq) const {
        { const int l_ = lane_opaque(); fr = l_ & 15; fq = l_ >> 4; }
        const int row0 = u.pm * 256 + wr * 64 + fr, cl = wc * 32 + 8 * fq;
#pragma unroll
        for (int ai = 0; ai < 2; ++ai)
#pragma unroll
            for (int m = 0; m < 4; ++m) {
#pragma unroll
                for (int bj = 0; bj < 2; ++bj) {
                    const size_t off = (size_t)(row0 + ai * 128 + m * 16);
                    const int col = u.pn * 256 + bj * 128 + cl;
                    const u32x4 gb = *(const u32x4*)(GATE + off * 4096 + 2048 + col);
                    const f32x4 a0 = acc[ai][bj][m][0], a1 = acc[ai][bj][m][1];
                    float v[8] = {a0[0] * bf_lo(gb.x), a0[1] * bf_hi(gb.x), a0[2] * bf_lo(gb.y), a0[3] * bf_hi(gb.y), a1[0] * bf_lo(gb.z), a1[1] * bf_hi(gb.z), a1[2] * bf_lo(gb.w), a1[3] * bf_hi(gb.w)};
                    st8(MERGED + off * 2048 + col, v);
                    asm volatile("" ::: "memory");
                }
            }
    }
};

struct EpiOut {
    static constexpr bool PERM = false, HAS_MID = false;
    const float* xin; float* xout; const float* gate;   const float* gnorm_next; const float* scale_next;
    bf16_t* XG; float* ssqx;
    __device__ __forceinline__ void mid(AccM, const Unit&, int, int, int, int) const {}
    __device__ __forceinline__ void operator()(AccC acc, const Unit& u, int wr, int wc, int fr, int fq) const {
        { const int l_ = lane_opaque(); fr = l_ & 15; fq = l_ >> 4; }
        const int row0 = u.pm * 256 + wr * 64 + fr, b = u.pm >> 4, col0 = u.pn * 256 + wc * 32 + 4 * fq;
        f32x4 gt[2][2], gn[2][2];
#pragma unroll
        for (int bj = 0; bj < 2; ++bj)
#pragma unroll
            for (int n = 0; n < 2; ++n) { const int col = col0 + bj * 128 + n * 16; gt[bj][n] = *(const f32x4*)(gate + (size_t)b * 6144 + col);
                if (scale_next) { const f32x4 g = *(const f32x4*)(gnorm_next + col), s = *(const f32x4*)(scale_next + (size_t)b * 6144 + col); gn[bj][n] = g * (s + 1.0f); } else gn[bj][n] = (f32x4){0.f, 0.f, 0.f, 0.f}; }
#pragma unroll
        for (int ai = 0; ai < 2; ++ai)
#pragma unroll
            for (int m = 0; m < 4; ++m) {
                const int row = row0 + ai * 128 + m * 16; float ss = 0.f;
#pragma unroll
                for (int bj = 0; bj < 2; ++bj)
#pragma unroll
                    for (int n = 0; n < 2; ++n) { const size_t off = (size_t)row * 2048 + col0 + bj * 128 + n * 16;
                        const f32x4 xo = *(const f32x4*)(xin + off); const f32x4 xn = xo + gt[bj][n] * acc[ai][bj][m][n];
                        *(f32x4*)(xout + off) = xn; ss += (xn[0] * xn[0] + xn[1] * xn[1]) + (xn[2] * xn[2] + xn[3] * xn[3]);
                        if (scale_next) { const f32x4 y = xn * gn[bj][n]; u32x2 w; w.x = cvt_pk_bf16(y[0], y[1]); w.y = cvt_pk_bf16(y[2], y[3]); *(u32x2*)(XG + off) = w; } }
                ss = xadd16(ss); ss = xadd32(ss);
                if (fq == 0) ssqx[(size_t)row * 32 + u.pn * 4 + wc] = ss;
                asm volatile("" ::: "memory");
            }
    }
};

namespace att {
constexpr int KVBLK = 64, QBLK = 32;
constexpr float SCALE = 0.07216878364870322f;
constexpr float THR = 8.f;
constexpr int LDQ = 3072, LDK = 3072, LDV = 2048;
constexpr int SHM_V = KVBLK * 128 * 2, SHM_K = KVBLK * 192 * 2;
#define KSWZ(row, colB) ((row) * 384 + ((colB) ^ (((row) & 7) << 4)))
#define SBAR() __builtin_amdgcn_sched_barrier(0)
__device__ __forceinline__ int crow(int r, int hi) { return (r & 3) + 8 * (r >> 2) + 4 * hi; }

__device__ __forceinline__ void partialSM(f32x16& p0, f32x16& p1, float& m_reg, float& mn, float& alpha) {
  constexpr float C = SCALE * 1.4426950408889634f;
  float pmax = p0[0];
#pragma unroll
  for (int r = 1; r < 16; ++r) pmax = fmaxf(pmax, p0[r]);
#pragma unroll
  for (int r = 0; r < 16; ++r) pmax = fmaxf(pmax, p1[r]);
  { auto rr = __builtin_amdgcn_permlane32_swap(__float_as_uint(pmax), __float_as_uint(pmax), false, false);
    pmax = fmaxf(__uint_as_float(rr[0]), __uint_as_float(rr[1])); }
  if (__builtin_expect(__all(pmax - m_reg <= THR / SCALE), 1)) { mn = m_reg; alpha = 1.f; }
  else { mn = fmaxf(m_reg, pmax); alpha = __builtin_amdgcn_exp2f((m_reg - mn) * C); m_reg = mn; }
  float mnC = -mn * C;
#pragma unroll
  for (int r = 0; r < 16; ++r) p0[r] = fmaf(p0[r], C, mnC);
#pragma unroll
  for (int r = 0; r < 16; ++r) p1[r] = fmaf(p1[r], C, mnC);
#pragma unroll
  for (int r = 0; r < 16; ++r) p0[r] = __builtin_amdgcn_exp2f(p0[r]);
}
__device__ __forceinline__ void finishSM(f32x16& p0, f32x16& p1, float alpha, float& l_reg, bf16x8& pa0, bf16x8& pa1, bf16x8& pa2, bf16x8& pa3) {
#pragma unroll
  for (int r = 0; r < 16; ++r) p1[r] = __builtin_amdgcn_exp2f(p1[r]);
  float ps = 0;
#pragma unroll
  for (int r = 0; r < 16; ++r) ps += p0[r];
#pragma unroll
  for (int r = 0; r < 16; ++r) ps += p1[r];
  { auto rr = __builtin_amdgcn_permlane32_swap(__float_as_uint(ps), __float_as_uint(ps), false, false);
    ps = __uint_as_float(rr[0]) + __uint_as_float(rr[1]); }
  l_reg = l_reg * alpha + ps;
#define PK4(P, BASE, OUT) do { unsigned a0 = cvt_pk_bf16(P[BASE + 0], P[BASE + 1]), a1 = cvt_pk_bf16(P[BASE + 2], P[BASE + 3]);   \
    unsigned b0 = cvt_pk_bf16(P[BASE + 4], P[BASE + 5]), b1 = cvt_pk_bf16(P[BASE + 6], P[BASE + 7]);                              \
    auto r0 = __builtin_amdgcn_permlane32_swap(a0, b0, false, false); auto r1 = __builtin_amdgcn_permlane32_swap(a1, b1, false, false); \
    u32x4 w = {r0[0], r1[0], r0[1], r1[1]}; OUT = *reinterpret_cast<bf16x8*>(&w); } while (0)
  PK4(p0, 0, pa0); PK4(p0, 8, pa1); PK4(p1, 0, pa2); PK4(p1, 8, pa3);
#undef PK4
}
__device__ __forceinline__ void qkt(f32x16& p0, f32x16& p1, const char* Ks, const bf16x8* qr, int r32, int hi) {
  p0 = f32x16{}; p1 = f32x16{};
#pragma unroll
  for (int d0 = 0; d0 < 12; ++d0) { int cb = (d0 * 16 + hi * 8) * 2;
    bf16x8 b0 = *reinterpret_cast<const bf16x8*>(Ks + KSWZ(r32, cb));
    bf16x8 b1 = *reinterpret_cast<const bf16x8*>(Ks + KSWZ(32 + r32, cb));
    p0 = __builtin_amdgcn_mfma_f32_32x32x16_bf16(b0, qr[d0], p0, 0, 0, 0);
    p1 = __builtin_amdgcn_mfma_f32_32x32x16_bf16(b1, qr[d0], p1, 0, 0, 0); }
}
__device__ __forceinline__ int v_st(int k, int c) { const int kk = (k & ~0xC) | ((k & 4) << 1) | ((k & 8) >> 1); return ((kk >> 3) * 4 + (c >> 5)) * 512 + ((kk & 7) * 32 + (c & 31)) * 2; }
__device__ __forceinline__ int v_rd_base(int lane) { return ((lane & 3) << 3) | (((lane >> 2) & 3) << 6) | (((lane >> 4) & 1) << 5) | (((lane >> 5) & 1) << 8); }
constexpr int v_rd_off(int d0, int ks, int half) { return d0 * 512 + ks * 4096 + half * 2048; }
template <int OFF> __device__ __forceinline__ s16x4 tr_read(int vb) {
  s16x4 r; asm volatile("ds_read_b64_tr_b16 %0, %1 offset:%2" : "=&v"(r) : "v"(vb), "i"(OFF) : "memory"); return r;
}
template <int D0> __device__ __forceinline__ void pv_one(f32x16& od, int vb, bf16x8 pa0, bf16x8 pa1, bf16x8 pa2, bf16x8 pa3) {
  const s16x4 l0 = tr_read<v_rd_off(D0, 0, 0)>(vb), h0 = tr_read<v_rd_off(D0, 0, 1)>(vb), l1 = tr_read<v_rd_off(D0, 1, 0)>(vb), h1 = tr_read<v_rd_off(D0, 1, 1)>(vb);
  const s16x4 l2 = tr_read<v_rd_off(D0, 2, 0)>(vb), h2 = tr_read<v_rd_off(D0, 2, 1)>(vb), l3 = tr_read<v_rd_off(D0, 3, 0)>(vb), h3 = tr_read<v_rd_off(D0, 3, 1)>(vb);
  asm volatile("s_waitcnt lgkmcnt(0)" ::: "memory"); SBAR();
#define PK(L, H) (bf16x8){L[0], L[1], L[2], L[3], H[0], H[1], H[2], H[3]}
  od = __builtin_amdgcn_mfma_f32_32x32x16_bf16(pa0, PK(l0, h0), od, 0, 0, 0);
  od = __builtin_amdgcn_mfma_f32_32x32x16_bf16(pa1, PK(l1, h1), od, 0, 0, 0);
  od = __builtin_amdgcn_mfma_f32_32x32x16_bf16(pa2, PK(l2, h2), od, 0, 0, 0);
  od = __builtin_amdgcn_mfma_f32_32x32x16_bf16(pa3, PK(l3, h3), od, 0, 0, 0);
#undef PK
}
__device__ __forceinline__ void pv_d0(f32x16* o, int vb, bf16x8 pa0, bf16x8 pa1, bf16x8 pa2, bf16x8 pa3) {
  pv_one<0>(o[0], vb, pa0, pa1, pa2, pa3); pv_one<1>(o[1], vb, pa0, pa1, pa2, pa3); pv_one<2>(o[2], vb, pa0, pa1, pa2, pa3); pv_one<3>(o[3], vb, pa0, pa1, pa2, pa3);
}

__device__ __forceinline__ void attn_item(const bf16_t* __restrict__ Qb, const bf16_t* __restrict__ Kh, const bf16_t* __restrict__ Vh, bf16_t* __restrict__ Ob, const bf16_t* __restrict__ Gb, int qb, char* lds) {
  const int tid = tid_opaque(), wid = tid >> 6, lane = tid & 63, r32 = lane & 31, hi = lane >> 5;
  char* V_lds = lds; char* K_lds = lds + 2 * SHM_V;
  float* wsl = (float*)(lds + 2 * SHM_V + 2 * SHM_K) + wid * 64; float* li_l = wsl; float* al_l = wsl + 32;
  float m_reg = -1e30f, l_reg = 0; f32x16 o[4] = {}; bf16x8 qr[12];
  const bf16_t* Qw = Qb + (size_t)(wid * QBLK + r32) * LDQ + hi * 8;
#pragma unroll
  for (int d0 = 0; d0 < 12; ++d0) qr[d0] = *reinterpret_cast<const bf16x8*>(Qw + d0 * 16);
  const int sr = tid >> 4, sc = (tid & 15) * 8, vst0 = v_st(sr, sc), vst1 = v_st(32 + sr, sc);
  int kgo[3], klo[3];
#pragma unroll
  for (int i = 0; i < 3; ++i) { const int q = tid + 512 * i, kr_ = q / 24, kc_ = (q % 24) * 8; kgo[i] = kr_ * LDK + kc_; klo[i] = KSWZ(kr_, kc_ * 2); }
  const int vgo = sr * LDV + sc;
  const int vb0 = (int)(uintptr_t)V_lds + v_rd_base(lane);
  bf16x8 vs0, vs1, ks0, ks1, ks2;
  const int NT = 4 * qb + 4, cwt = 4 * qb + (wid >> 1);
#define SLOAD(k0) do { const bf16_t* vp_ = Vh + (size_t)(k0) * LDV + vgo; const bf16_t* kp_ = Kh + (size_t)(k0) * LDK; \
    vs0 = *reinterpret_cast<const bf16x8*>(vp_); vs1 = *reinterpret_cast<const bf16x8*>(vp_ + 32 * LDV); \
    ks0 = *reinterpret_cast<const bf16x8*>(kp_ + kgo[0]); ks1 = *reinterpret_cast<const bf16x8*>(kp_ + kgo[1]); ks2 = *reinterpret_cast<const bf16x8*>(kp_ + kgo[2]); } while (0)
#define SWRITE(b) do { *(bf16x8*)(V_lds + (b) * SHM_V + vst0) = vs0; *(bf16x8*)(V_lds + (b) * SHM_V + vst1) = vs1; \
    *(bf16x8*)(K_lds + (b) * SHM_K + klo[0]) = ks0; *(bf16x8*)(K_lds + (b) * SHM_K + klo[1]) = ks1; *(bf16x8*)(K_lds + (b) * SHM_K + klo[2]) = ks2; } while (0)
#define SWAIT() asm volatile("s_waitcnt vmcnt(0)" ::: "memory")
#define RESC(a) do { if (__any((a) < 1.f)) { if (hi == 0) al_l[r32] = (a); asm volatile("s_waitcnt lgkmcnt(0)" ::: "memory"); \
    _Pragma("unroll") for (int d = 0; d < 4; ++d) _Pragma("unroll") for (int r = 0; r < 16; ++r) o[d][r] *= al_l[crow(r, hi)]; } } while (0)
#define QKT(P0, P1, KB_, j) do { if ((j) <= cwt) qkt(P0, P1, KB_, qr, r32, hi); else { _Pragma("unroll") for (int r_ = 0; r_ < 16; ++r_) { P0[r_] = -1e30f; P1[r_] = -1e30f; } } } while (0)
#define PV(vb_, j) do { if ((j) <= cwt) pv_d0(o, vb_, pa0, pa1, pa2, pa3); } while (0)
  f32x16 pA0, pA1, pB0, pB1; float mnA, mnB, alA, alB; bf16x8 pa0, pa1, pa2, pa3;
  SLOAD(0); SWAIT(); SWRITE(0); __syncthreads();
  QKT(pA0, pA1, K_lds, 0); partialSM(pA0, pA1, m_reg, mnA, alA);
  SLOAD(KVBLK);
  SWAIT(); SWRITE(1); __syncthreads();
  for (int j = 1; j + 1 < NT; j += 2) {
    SBAR(); QKT(pB0, pB1, K_lds + SHM_K, j);
    finishSM(pA0, pA1, alA, l_reg, pa0, pa1, pa2, pa3); SBAR();
    SLOAD((j + 1) * KVBLK); SBAR();
    PV(vb0, j - 1); partialSM(pB0, pB1, m_reg, mnB, alB);
    __syncthreads(); SWAIT(); SWRITE(0);
    RESC(alB); __syncthreads();
    SBAR(); QKT(pA0, pA1, K_lds, j + 1);
    finishSM(pB0, pB1, alB, l_reg, pa0, pa1, pa2, pa3); SBAR();
    SLOAD((j + 2) * KVBLK); SBAR();
    PV(vb0 + SHM_V, j); partialSM(pA0, pA1, m_reg, mnA, alA);
    __syncthreads(); SWAIT(); SWRITE(1);
    RESC(alA); __syncthreads();
  }
  SBAR(); QKT(pB0, pB1, K_lds + SHM_K, NT - 1);
  finishSM(pA0, pA1, alA, l_reg, pa0, pa1, pa2, pa3); SBAR();
  PV(vb0, NT - 2); partialSM(pB0, pB1, m_reg, mnB, alB);
  __syncthreads(); RESC(alB);
  finishSM(pB0, pB1, alB, l_reg, pa0, pa1, pa2, pa3); SBAR();
  PV(vb0 + SHM_V, NT - 1);
  if (hi == 0) li_l[r32] = l_reg; asm volatile("s_waitcnt lgkmcnt(0)" ::: "memory");
  float rli[16];
#pragma unroll
  for (int r = 0; r < 16; ++r) rli[r] = __builtin_amdgcn_rcpf(li_l[crow(r, hi)]);
#pragma unroll
  for (int r = 0; r < 16; ++r) { const int orow = wid * QBLK + crow(r, hi);
#pragma unroll
    for (int d0 = 0; d0 < 4; ++d0) { const float g = bf2f(Gb[(size_t)orow * 2048 + d0 * 32 + r32]); Ob[(size_t)orow * 4096 + d0 * 32 + r32] = f2bf(o[d0][r] * rli[r] * g); } }
  __syncthreads();
#undef SLOAD
#undef SWRITE
#undef SWAIT
#undef RESC
#undef QKT
#undef PV
}
}

namespace ret {
constexpr int QS_STRIDE = 272, T_STRIDE = 144;
constexpr int OFF_QS = 0, OFF_KS = 64 * QS_STRIDE, OFF_KZT = OFF_KS + 64 * QS_STRIDE, OFF_VT = OFF_KZT + 128 * T_STRIDE, OFF_SP = OFF_VT + 256 * T_STRIDE, OFF_ST = OFF_SP + 64 * T_STRIDE, OFF_END = OFF_ST + 8 * 64 * 8;
static_assert(OFF_END <= LDS_BYTES, "retention LDS");
__device__ __forceinline__ int crow(int r, int hi) { return (r & 3) + 8 * (r >> 2) + 4 * hi; }

__device__ __forceinline__ void worker(const bf16_t* __restrict__ RQ, const bf16_t* __restrict__ RK, const bf16_t* __restrict__ RV, const bf16_t* __restrict__ SRG, bf16_t* __restrict__ AR, int b, int h, char* lds) {
  const int tid = tid_opaque(), wid = tid >> 6, lane = tid & 63, r32 = lane & 31, hi = lane >> 5, fr = lane & 15, fq = lane >> 4;
  char* Qs = lds + OFF_QS; char* Ks = lds + OFF_KS; char* KzT = lds + OFF_KZT; char* VT = lds + OFF_VT; char* Sp = lds + OFF_SP; float* St = (float*)(lds + OFF_ST);
  const float lg2 = log2f(1.0f - exp2f(-5.0f - (float)h));
  const int j_st = tid & 63, cb = tid >> 6;
  const float zeta = exp2f((float)(63 - j_st) * lg2), dchunk = exp2f(64.0f * lg2);
  float xi[2]; xi[0] = exp2f((float)(r32 + 1) * lg2); xi[1] = exp2f((float)(32 + r32 + 1) * lg2);
  f32x16 R[4];
#pragma unroll
  for (int d = 0; d < 4; ++d) R[d] = f32x16{};
  bf16x8 pq[2], pk[2], pv[4];
  const size_t tok0 = (size_t)b * SEQ;
#define RLOAD(n) do { const size_t t_ = tok0 + (size_t)(n) * 64 + j_st; \
    _Pragma("unroll") for (int i = 0; i < 2; ++i) { pq[i] = *reinterpret_cast<const bf16x8*>(RQ + t_ * 1024 + h * 128 + (cb + 8 * i) * 8); pk[i] = *reinterpret_cast<const bf16x8*>(RK + t_ * 1024 + h * 128 + (cb + 8 * i) * 8); } \
    _Pragma("unroll") for (int i = 0; i < 4; ++i) pv[i] = *reinterpret_cast<const bf16x8*>(RV + t_ * 2048 + h * 256 + (cb + 8 * i) * 8); } while (0)
  RLOAD(0);
  for (int n = 0; n < 64; ++n) {
#pragma unroll
    for (int i = 0; i < 2; ++i) {
      *(bf16x8*)(Qs + j_st * QS_STRIDE + (cb + 8 * i) * 16) = pq[i];
      *(bf16x8*)(Ks + j_st * QS_STRIDE + (cb + 8 * i) * 16) = pk[i];
#pragma unroll
      for (int t = 0; t < 8; ++t) *(bf16_t*)(KzT + ((cb + 8 * i) * 8 + t) * T_STRIDE + j_st * 2) = f2bf(bf2f((bf16_t)pk[i][t]) * zeta);
    }
#pragma unroll
    for (int i = 0; i < 4; ++i)
#pragma unroll
      for (int t = 0; t < 8; ++t) *(bf16_t*)(VT + ((cb + 8 * i) * 8 + t) * T_STRIDE + j_st * 2) = (bf16_t)pv[i][t];
    __syncthreads();
    if (n + 1 < 64) RLOAD(n + 1);
    {
      const int ti = wid >> 1, tj0 = (wid & 1) * 2;
      f32x4 s0 = {0.f, 0.f, 0.f, 0.f}, s1 = {0.f, 0.f, 0.f, 0.f};
#pragma unroll
      for (int kk = 0; kk < 4; ++kk) {
        const bf16x8 bq = *(const bf16x8*)(Qs + (ti * 16 + fr) * QS_STRIDE + (kk * 32 + fq * 8) * 2);
        const bf16x8 a0 = *(const bf16x8*)(Ks + (tj0 * 16 + fr) * QS_STRIDE + (kk * 32 + fq * 8) * 2);
        const bf16x8 a1 = *(const bf16x8*)(Ks + ((tj0 + 1) * 16 + fr) * QS_STRIDE + (kk * 32 + fq * 8) * 2);
        s0 = __builtin_amdgcn_mfma_f32_16x16x32_bf16(a0, bq, s0, 0, 0, 0);
        s1 = __builtin_amdgcn_mfma_f32_16x16x32_bf16(a1, bq, s1, 0, 0, 0);
      }
      const int it = ti * 16 + fr;
#pragma unroll
      for (int t2 = 0; t2 < 2; ++t2) { const int jb = (tj0 + t2) * 16 + 4 * fq; const f32x4 s = t2 ? s1 : s0; float w[4];
#pragma unroll
        for (int r = 0; r < 4; ++r) { const int dd = it - (jb + r); w[r] = s[r] * exp2f((float)(dd < 0 ? -dd : dd) * lg2); }
        u32x2 pk2; pk2.x = cvt_pk_bf16(w[0], w[1]); pk2.y = cvt_pk_bf16(w[2], w[3]); *(u32x2*)(Sp + it * T_STRIDE + jb * 2) = pk2; }
    }
    __syncthreads();
    f32x16 oc[2]; oc[0] = f32x16{}; oc[1] = f32x16{};
#pragma unroll
    for (int dt = 0; dt < 4; ++dt)
#pragma unroll
      for (int sp = 0; sp < 2; ++sp) {
        u32x4 aw; aw.x = cvt_pk_bf16(R[dt][8 * sp + 0], R[dt][8 * sp + 1]); aw.y = cvt_pk_bf16(R[dt][8 * sp + 2], R[dt][8 * sp + 3]);
        aw.z = cvt_pk_bf16(R[dt][8 * sp + 4], R[dt][8 * sp + 5]); aw.w = cvt_pk_bf16(R[dt][8 * sp + 6], R[dt][8 * sp + 7]);
        const bf16x8 A = *reinterpret_cast<bf16x8*>(&aw);
#pragma unroll
        for (int it = 0; it < 2; ++it) { const char* bp = Qs + (32 * it + r32) * QS_STRIDE + (32 * dt + 16 * sp + 4 * hi) * 2;
          const s16x4 lo = *(const s16x4*)bp, h4 = *(const s16x4*)(bp + 16);
          const bf16x8 B = (bf16x8){lo[0], lo[1], lo[2], lo[3], h4[0], h4[1], h4[2], h4[3]};
          oc[it] = __builtin_amdgcn_mfma_f32_32x32x16_bf16(A, B, oc[it], 0, 0, 0); }
      }
#pragma unroll
    for (int it = 0; it < 2; ++it)
#pragma unroll
      for (int r = 0; r < 16; ++r) oc[it][r] *= xi[it];
    bf16x8 vfr[4];
#pragma unroll
    for (int ks = 0; ks < 4; ++ks) vfr[ks] = *(const bf16x8*)(VT + (32 * wid + r32) * T_STRIDE + (16 * ks + 8 * hi) * 2);
#pragma unroll
    for (int it = 0; it < 2; ++it)
#pragma unroll
      for (int ks = 0; ks < 4; ++ks) { const bf16x8 B = *(const bf16x8*)(Sp + (32 * it + r32) * T_STRIDE + (16 * ks + 8 * hi) * 2);
        oc[it] = __builtin_amdgcn_mfma_f32_32x32x16_bf16(vfr[ks], B, oc[it], 0, 0, 0); }
#pragma unroll
    for (int dt = 0; dt < 4; ++dt) {
#pragma unroll
      for (int r = 0; r < 16; ++r) R[dt][r] *= dchunk;
#pragma unroll
      for (int ks = 0; ks < 4; ++ks) { const bf16x8 A = *(const bf16x8*)(KzT + (32 * dt + r32) * T_STRIDE + (16 * ks + 8 * hi) * 2);
        R[dt] = __builtin_amdgcn_mfma_f32_32x32x16_bf16(A, vfr[ks], R[dt], 0, 0, 0); }
    }
#pragma unroll
    for (int it = 0; it < 2; ++it) { float s1 = 0.f, s2 = 0.f;
#pragma unroll
      for (int r = 0; r < 16; ++r) { s1 += oc[it][r]; s2 += oc[it][r] * oc[it][r]; }
      s1 = xadd32(s1); s2 = xadd32(s2);
      if (hi == 0) *(f32x2*)(St + (wid * 64 + 32 * it + r32) * 2) = (f32x2){s1, s2}; }
    __syncthreads();
#pragma unroll
    for (int it = 0; it < 2; ++it) { float S1 = 0.f, S2 = 0.f;
#pragma unroll
      for (int w = 0; w < 8; ++w) { const f32x2 v = *(const f32x2*)(St + (w * 64 + 32 * it + r32) * 2); S1 += v.x; S2 += v.y; }
      const float mu = S1 * (1.0f / 256.0f), var = S2 * (1.0f / 256.0f) - mu * mu, rstd = rsqrtf(fmaxf(var, 0.f) + EPS);
      const size_t t = tok0 + (size_t)n * 64 + 32 * it + r32;
#pragma unroll
      for (int g = 0; g < 4; ++g) { const int e = h * 256 + 32 * wid + 8 * g + 4 * hi;
        const u32x2 gw = *(const u32x2*)(SRG + t * 2048 + e);
        u32x2 ow; ow.x = cvt_pk_bf16((oc[it][4 * g + 0] - mu) * rstd * bf_lo(gw.x), (oc[it][4 * g + 1] - mu) * rstd * bf_hi(gw.x));
        ow.y = cvt_pk_bf16((oc[it][4 * g + 2] - mu) * rstd * bf_lo(gw.y), (oc[it][4 * g + 3] - mu) * rstd * bf_hi(gw.y));
        *(u32x2*)(AR + t * 4096 + e) = ow; }
    }
  }
  __syncthreads();
#undef RLOAD
}
}

__device__ __forceinline__ int src_in(int n) {
    if (n < 2048) { const int base = n & ~1023, r = n & 1023, hd = r >> 7, p = r & 127; return base + hd * 128 + (p >> 1) + 64 * (p & 1); }
    if (n < 7168) return n;
    if (n < 9216) return n + 64;
    if (n < 13312) return n + 64;
    if (n < 13376) { const int p = n - 13312; return 7168 + (p >> 1) + 32 * (p & 1); }
    return -1;
}
__device__ __forceinline__ int src_q(int n) {
    if (n < 2048) return (n >> 7) * 192 + (n & 127);
    const int r = n - 2048, hd = r >> 6, p = r & 63; return hd * 192 + 128 + (p >> 1) + 32 * (p & 1);
}
__device__ __forceinline__ int src_kv(int n) {
    if (n < 2048) return (n >> 7) * 256 + (n & 127);
    const int r = n - 2048; return (r >> 7) * 256 + 128 + (r & 127);
}

constexpr int CV_T_IN = (DINP / 64) * 32, CV_T_Q = (NQ / 64) * 8, CV_T_KV = (NKV / 64) * 8, CV_T_SQ = 32 * 32;
constexpr int CV_PER_LAYER = CV_T_IN + CV_T_Q + CV_T_KV + 3 * CV_T_SQ, CV_TOTAL = DEPTH * CV_PER_LAYER;

struct CvTile { const float* src; int nsrc; int scol; bf16_t* dst; const float* ksc; };
__device__ __forceinline__ void cv_decode(const Params& P, int tile, int nl, CvTile& c, int& dstride) {
    const int l = tile / CV_PER_LAYER; int r = tile % CV_PER_LAYER; unsigned char* ws = P.ws;
    if (r < CV_T_IN) { const int tn = r >> 5, tk = r & 31; c.nsrc = DIN; c.src = P.w_in + (size_t)l * DM * DIN + (size_t)tk * 64 * DIN; c.scol = src_in(tn * 64 + nl);
        dstride = DM; c.dst = (bf16_t*)(ws + WS_WT_IN + l * SZ_WT_IN) + (size_t)tn * 64 * DM + tk * 64; c.ksc = nullptr; return; }
    r -= CV_T_IN;
    if (r < CV_T_Q) { const int tn = r >> 3, tk = r & 7; c.nsrc = NQ; c.src = P.w_uq + (size_t)l * 512 * NQ + (size_t)tk * 64 * NQ; c.scol = src_q(tn * 64 + nl);
        dstride = 512; c.dst = (bf16_t*)(ws + WS_WT_Q + l * SZ_WT_Q) + (size_t)tn * 64 * 512 + tk * 64; c.ksc = P.g_cq + l * 512 + tk * 64; return; }
    r -= CV_T_Q;
    if (r < CV_T_KV) { const int tn = r >> 3, tk = r & 7; c.nsrc = NKV; c.src = P.w_ukv + (size_t)l * 512 * NKV + (size_t)tk * 64 * NKV; c.scol = src_kv(tn * 64 + nl);
        dstride = 512; c.dst = (bf16_t*)(ws + WS_WT_KV + l * SZ_WT_KV) + (size_t)tn * 64 * 512 + tk * 64; c.ksc = P.g_ckv + l * 512 + tk * 64; return; }
    r -= CV_T_KV;
    const int which = r / CV_T_SQ; r %= CV_T_SQ; const int tn = r >> 5, tk = r & 31;
    const size_t soff = (size_t)l * DM * DM + (size_t)tk * 64 * DM;
    c.nsrc = DM; c.scol = tn * 64 + nl; c.ksc = nullptr;
    if (which == 0) { c.src = P.w_ret + soff; dstride = 4096; c.dst = (bf16_t*)(ws + WS_WT_RM + l * SZ_WT_RM) + (size_t)tn * 64 * 4096 + tk * 64; return; }
    if (which == 1) { c.src = P.w_mla + soff; dstride = 4096; c.dst = (bf16_t*)(ws + WS_WT_RM + l * SZ_WT_RM) + (size_t)tn * 64 * 4096 + 2048 + tk * 64; return; }
    c.src = P.w_out + soff; dstride = DM; c.dst = (bf16_t*)(ws + WS_WT_O + l * SZ_WT_O) + (size_t)tn * 64 * DM + tk * 64;
}

__device__ __forceinline__ void phase_p0a(const Params& P, char* lds) {
    const int tid = tid_opaque(), G = gridDim.x, bid = blockIdx.x;
    float* cosr = (float*)(P.ws + WS_COSR); float* sinr = (float*)(P.ws + WS_SINR); float* cosm = (float*)(P.ws + WS_COSM); float* sinm = (float*)(P.ws + WS_SINM);
    for (int i = bid * NTHREADS + tid; i < T_TOK * 96; i += G * NTHREADS) {
        const int t = i / 96, j = i % 96; const float pos = (float)P.pos[t];
        const int jj = j < 64 ? j : j - 64; const float inv = j < 64 ? P.inv_r[jj] : P.inv_m[jj]; const float a = pos * inv;
        const float kf = rintf(a * 0.15915494309189535f); float r = fmaf(-kf, 6.28125f, a); r = fmaf(-kf, 0.0019354820251464844f, r); r = fmaf(-kf, -1.7484555314695172e-07f, r);
        const float rf = r * 0.15915494309189535f; const float cv = __builtin_amdgcn_cosf(rf), sv = __builtin_amdgcn_sinf(rf);
        if (j < 64) { cosr[t * 64 + jj] = cv; sinr[t * 64 + jj] = sv; } else { cosm[t * 32 + jj] = cv; sinm[t * 32 + jj] = sv; }
    }
    {
        float* cact = (float*)lds; float* part = (float*)(lds + 32768);
        for (int i = tid; i < 4 * 2048; i += NTHREADS) cact[i] = silu_f(P.c[i]);
        __syncthreads();
        float* mod = (float*)(P.ws + WS_MOD);
        const int cn = tid & 63, ks = tid >> 6;
        for (int item = bid; item < DEPTH * 96; item += G) {
            const int l = item / 96, n0 = (item % 96) * 64;
            const float* wp = P.w_mod + ((size_t)l * DM + ks * 256) * 6144 + n0 + cn;
            float a0 = 0.f, a1 = 0.f, a2 = 0.f, a3 = 0.f;
#pragma unroll 8
            for (int k = 0; k < 256; ++k) { const float w = wp[(size_t)k * 6144]; const int kk = ks * 256 + k; a0 += cact[kk] * w; a1 += cact[2048 + kk] * w; a2 += cact[4096 + kk] * w; a3 += cact[6144 + kk] * w; }
            *(f32x4*)(part + (ks * 64 + cn) * 4) = (f32x4){a0, a1, a2, a3};
            __syncthreads();
            if (tid < 256) { const int c2 = tid & 63, b = tid >> 6; float s = P.b_mod[l * 6144 + n0 + c2];
#pragma unroll
                for (int q = 0; q < 8; ++q) s += part[(q * 64 + c2) * 4 + b];
                mod[((size_t)l * 4 + b) * 6144 + n0 + c2] = s; }
            __syncthreads();
        }
    }
    {
        float* tl = (float*)lds;
        const int nl = tid & 63, kr = tid >> 6;
        float v[8]; CvTile c; int dstride = 0;
        int tile = bid;
        if (tile < CV_TOTAL) { cv_decode(P, tile, nl, c, dstride);
#pragma unroll
            for (int i = 0; i < 8; ++i) v[i] = c.scol >= 0 ? c.src[(size_t)(kr + 8 * i) * c.nsrc + c.scol] : 0.f; }
        while (tile < CV_TOTAL) {
#pragma unroll
            for (int i = 0; i < 8; ++i) tl[(kr + 8 * i) * 65 + nl] = v[i];
            __syncthreads();
            bf16_t* dst = c.dst; const int ds = dstride; const float sc = c.ksc ? c.ksc[nl] : 1.0f;
            const int nxt = tile + G;
            if (nxt < CV_TOTAL) { cv_decode(P, nxt, nl, c, dstride);
#pragma unroll
                for (int i = 0; i < 8; ++i) v[i] = c.scol >= 0 ? c.src[(size_t)(kr + 8 * i) * c.nsrc + c.scol] : 0.f; }
#pragma unroll
            for (int i = 0; i < 8; ++i) { const int nn = kr + 8 * i; dst[(size_t)nn * ds + nl] = f2bf(tl[nl * 65 + nn] * sc); }
            __syncthreads();
            tile = nxt;
        }
    }
}

__device__ __forceinline__ void phase_p0b(const Params& P) {
    const int tid = tid_opaque(), lane = tid & 63, gw = blockIdx.x * 8 + (tid >> 6), GW = gridDim.x * 8;
    const float* mod = (const float*)(P.ws + WS_MOD);
    bf16_t* XG = (bf16_t*)(P.ws + WS_XG); float* ssqx = (float*)(P.ws + WS_SSQX);
    for (int row = gw; row < T_TOK; row += GW) {
        const int b = row >> 12; float ss = 0.f;
#pragma unroll
        for (int i = 0; i < 8; ++i) { const int col = (i * 64 + lane) * 4; const f32x4 x = *(const f32x4*)(P.x + (size_t)row * DM + col);
            const f32x4 g = *(const f32x4*)(P.g_norm + col), s = *(const f32x4*)(mod + (size_t)b * 6144 + 2048 + col); const f32x4 y = x * g * (s + 1.0f);
            ss += (x[0] * x[0] + x[1] * x[1]) + (x[2] * x[2] + x[3] * x[3]);
            u32x2 w; w.x = cvt_pk_bf16(y[0], y[1]); w.y = cvt_pk_bf16(y[2], y[3]); *(u32x2*)(XG + (size_t)row * DM + col) = w; }
#pragma unroll
        for (int o = 32; o >= 1; o >>= 1) ss += __shfl_xor(ss, o);
        if (lane < 32) ssqx[(size_t)row * 32 + lane] = lane == 0 ? ss : 0.f;
    }
    float* bias2 = (float*)(P.ws + WS_BIAS2);
    for (int r = gw; r < DEPTH * DINP; r += GW) {
        const int l = r / DINP, n = r % DINP;
        const bf16_t* wrow = (const bf16_t*)(P.ws + WS_WT_IN + l * SZ_WT_IN) + (size_t)n * DM;
        float a[4] = {0.f, 0.f, 0.f, 0.f};
#pragma unroll
        for (int i = 0; i < 4; ++i) { const int k = (i * 64 + lane) * 8; const u32x4 w = *(const u32x4*)(wrow + k);
            const float wf[8] = {bf_lo(w.x), bf_hi(w.x), bf_lo(w.y), bf_hi(w.y), bf_lo(w.z), bf_hi(w.z), bf_lo(w.w), bf_hi(w.w)};
#pragma unroll
            for (int b = 0; b < 4; ++b) { const float* sp = mod + ((size_t)l * 4 + b) * 6144 + k; const f32x4 s0 = *(const f32x4*)sp, s1 = *(const f32x4*)(sp + 4);
                a[b] += (wf[0] * s0[0] + wf[1] * s0[1]) + (wf[2] * s0[2] + wf[3] * s0[3]) + (wf[4] * s1[0] + wf[5] * s1[1]) + (wf[6] * s1[2] + wf[7] * s1[3]); } }
#pragma unroll
        for (int b = 0; b < 4; ++b) {
#pragma unroll
            for (int o = 32; o >= 1; o >>= 1) a[b] += __shfl_xor(a[b], o); }
        if (lane < 4) bias2[((size_t)l * 4 + lane) * DINP + n] = lane == 0 ? a[0] : lane == 1 ? a[1] : lane == 2 ? a[2] : a[3];
    }
}

__device__ __forceinline__ void phase_final(const Params& P) {
    const int tid = tid_opaque(), lane = tid & 63, gw = blockIdx.x * 8 + (tid >> 6), GW = gridDim.x * 8;
    const float* ssqx = (const float*)(P.ws + WS_SSQX);
    for (int row = gw; row < T_TOK; row += GW) {
        float ss = lane < 32 ? ssqx[(size_t)row * 32 + lane] : 0.f;
#pragma unroll
        for (int o = 32; o >= 1; o >>= 1) ss += __shfl_xor(ss, o);
        const float rinv = rsqrtf(ss * (1.0f / 2048.0f) + EPS);
#pragma unroll
        for (int i = 0; i < 8; ++i) { const int col = (i * 64 + lane) * 4; float* p = P.out + (size_t)row * DM + col; const f32x4 x = *(const f32x4*)p; const f32x4 g = *(const f32x4*)(P.g_final + col);
            *(f32x4*)p = x * rinv * g; }
    }
}

constexpr int N_PHASES = 2 + 5 * DEPTH + 1;

template <int S_>
__device__ __forceinline__ void layer_phase(const Params& P, int l, unsigned char* lds_raw) {
    __attribute__((address_space(1))) unsigned char* wsg = (__attribute__((address_space(1))) unsigned char*)P.ws; asm volatile("" : "+s"(wsg)); unsigned char* ws = (unsigned char*)wsg;
    char* lds = (char*)lds_raw; PG8_LAS unsigned char* lds3 = (PG8_LAS unsigned char*)lds_raw;
    const int G = gridDim.x; int bid = blockIdx.x; asm volatile("" : "+s"(bid));
    float* ssqx = (float*)(ws + WS_SSQX); float* ssqc = (float*)(ws + WS_SSQC);
    const float* cosr = (const float*)(ws + WS_COSR); const float* sinr = (const float*)(ws + WS_SINR); const float* cosm = (const float*)(ws + WS_COSM); const float* sinm = (const float*)(ws + WS_SINM);
    bf16_t* XG = (bf16_t*)(ws + WS_XG); bf16_t* RQ = (bf16_t*)(ws + WS_RQ); bf16_t* RK = (bf16_t*)(ws + WS_RK); bf16_t* RV = (bf16_t*)(ws + WS_RV); bf16_t* SRG = (bf16_t*)(ws + WS_SRG); bf16_t* SMG = (bf16_t*)(ws + WS_SMG);
    bf16_t* CQ = (bf16_t*)(ws + WS_CQ); bf16_t* CKV = (bf16_t*)(ws + WS_CKV); bf16_t* GATE = (bf16_t*)(ws + WS_GATE); bf16_t* QB = (bf16_t*)(ws + WS_QB); bf16_t* KB = (bf16_t*)(ws + WS_KB); bf16_t* VB = (bf16_t*)(ws + WS_VB);
    bf16_t* AR = (bf16_t*)(ws + WS_AR); bf16_t* MERGED = (bf16_t*)(ws + WS_MERGED);
    const float* mod = (const float*)(ws + WS_MOD);
    if constexpr (S_ == 0) {
        pg8::Gemm g{XG, (const bf16_t*)(ws + WS_WT_IN + l * SZ_WT_IN), T_TOK, DINP, DM}; pg8::StaticOrder S; S.init(T_TOK, DINP, G, bid);
        EpiIn E{ssqx, (const float*)(ws + WS_BIAS2) + (size_t)l * 4 * DINP, cosr, sinr, cosm, sinm, RQ, RK, RV, SRG, CQ, CKV, SMG, GATE, KB, ssqc};
        pg8::gemm_phase<EpiIn, pg8::StaticOrder>(lds3, g, S, E);
    } else if constexpr (S_ == 1) {
        { pg8::Gemm g{CQ, (const bf16_t*)(ws + WS_WT_Q + l * SZ_WT_Q), T_TOK, NQ, 512}; pg8::StaticOrder S; S.init(T_TOK, NQ, G, bid);
          EpiUp<0> E{ssqc, cosm, sinm, QB, KB, VB}; pg8::gemm_phase<EpiUp<0>, pg8::StaticOrder>(lds3, g, S, E); }
        { pg8::Gemm g{CKV, (const bf16_t*)(ws + WS_WT_KV + l * SZ_WT_KV), T_TOK, NKV, 512}; pg8::StaticOrder S; S.init(T_TOK, NKV, G, bid);
          EpiUp<1> E{ssqc, cosm, sinm, QB, KB, VB}; pg8::gemm_phase<EpiUp<1>, pg8::StaticOrder>(lds3, g, S, E); }
    } else if constexpr (S_ == 2) {
#if defined(SKIP_RET)
        for (size_t i = (size_t)bid * NTHREADS + threadIdx.x; i < (size_t)T_TOK * 256; i += (size_t)G * NTHREADS) { const size_t t = i >> 8, c = (i & 255) * 8; *(u32x4*)(AR + t * 4096 + c) = *(const u32x4*)(SRG + t * 2048 + c); }
#else
        if (bid < 32) ret::worker(RQ, RK, RV, SRG, AR, bid >> 3, bid & 7, lds);
#endif
#if defined(SKIP_ATT)
        for (size_t i = (size_t)bid * NTHREADS + threadIdx.x; i < (size_t)T_TOK * 256; i += (size_t)G * NTHREADS) { const size_t t = i >> 8, c = (i & 255) * 8; *(u32x4*)(AR + t * 4096 + 2048 + c) = *(const u32x4*)(SMG + t * 2048 + c); }
        if (false)
#endif
        for (int it = bid; it < 1024; it += G) {
            const int k = it >> 8, ip = it & 255, a = ip >> 6, bh = ip & 63, b = bh >> 4, h = bh & 15;
            const int qb = k == 0 ? 15 - a : (k == 1 ? a : (k == 2 ? 11 - a : 4 + a));
            const size_t row0 = (size_t)b * SEQ + qb * 256;
            att::attn_item(QB + row0 * 3072 + h * 192, KB + (size_t)b * SEQ * 3072 + h * 192, VB + (size_t)b * SEQ * 2048 + h * 128, AR + row0 * 4096 + 2048 + h * 128, SMG + row0 * 2048 + h * 128, qb, lds);
        }
    } else if constexpr (S_ == 3) {
        pg8::Gemm g{AR, (const bf16_t*)(ws + WS_WT_RM + l * SZ_WT_RM), T_TOK, DM, 4096}; pg8::StaticOrder S; S.init(T_TOK, DM, G, bid);
        EpiMerge E{GATE, MERGED}; pg8::gemm_phase<EpiMerge, pg8::StaticOrder>(lds3, g, S, E);
    } else {
        pg8::Gemm g{MERGED, (const bf16_t*)(ws + WS_WT_O + l * SZ_WT_O), T_TOK, DM, DM}; pg8::StaticOrder S; S.init(T_TOK, DM, G, bid);
        const bool lastl = (l == DEPTH - 1);
        EpiOut E{l == 0 ? P.x : P.out, P.out, mod + (size_t)l * 4 * 6144 + 4096, lastl ? nullptr : P.g_norm + (l + 1) * DM, lastl ? nullptr : mod + (size_t)(l + 1) * 4 * 6144 + 2048, XG, ssqx};
        pg8::gemm_phase<EpiOut, pg8::StaticOrder>(lds3, g, S, E);
    }
}

__device__ __forceinline__ void run_phase(const Params& P, int ph, unsigned char* lds_raw) {
    if (ph == 0) { phase_p0a(P, (char*)lds_raw); return; }
    if (ph == 1) { phase_p0b(P); return; }
    if (ph == N_PHASES - 1) { phase_final(P); return; }
    const int l = (ph - 2) / 5, s = (ph - 2) % 5;
    if (s == 0) layer_phase<0>(P, l, lds_raw);
    else if (s == 1) layer_phase<1>(P, l, lds_raw);
    else if (s == 2) layer_phase<2>(P, l, lds_raw);
    else if (s == 3) layer_phase<3>(P, l, lds_raw);
    else layer_phase<4>(P, l, lds_raw);
}

#if MK_COOP
__global__ void __launch_bounds__(NTHREADS) hybrid_fwd(Params P) {
    extern __shared__ __attribute__((aligned(16))) unsigned char lds_raw[];
    for (int ph = P.ph_lo; ph < P.ph_hi; ++ph) {
        if (ph > P.ph_lo) cg::this_grid().sync();
        run_phase(P, ph, lds_raw);
    }
}
#else
__global__ void __launch_bounds__(NTHREADS) k_p0a(Params P) { extern __shared__ __attribute__((aligned(16))) unsigned char lds_raw[]; phase_p0a(P, (char*)lds_raw); }
__global__ void __launch_bounds__(NTHREADS) k_p0b(Params P) { phase_p0b(P); }
__global__ void __launch_bounds__(NTHREADS) k_final(Params P) { phase_final(P); }
template <int S_> __global__ void __launch_bounds__(NTHREADS) k_layer(Params P) { extern __shared__ __attribute__((aligned(16))) unsigned char lds_raw[]; layer_phase<S_>(P, P.ph_lo, lds_raw); }
#endif

extern "C" void kernel_launch(void* const* d_in, const int* in_sizes, int n_in, void* d_out, int out_size, void* d_ws, size_t ws_size, hipStream_t stream) {
    static int grid = 0;
    if (grid == 0) {
        if (n_in != 15 || out_size != T_TOK * DM || ws_size < WS_END) { fprintf(stderr, "kernel_launch: unexpected shapes (n_in %d, out %d, ws %zu < %zu)\n", n_in, out_size, ws_size, (size_t)WS_END); grid = -1; return; }
        int dev = 0, cus = 0; bool ok = true;
        ok = ok && hipGetDevice(&dev) == hipSuccess; ok = ok && hipDeviceGetAttribute(&cus, hipDeviceAttributeMultiprocessorCount, dev) == hipSuccess;
#if MK_COOP
        int per_cu = 0;
        ok = ok && hipFuncSetAttribute((const void*)hybrid_fwd, hipFuncAttributeMaxDynamicSharedMemorySize, LDS_BYTES) == hipSuccess;
        if (hipOccupancyMaxActiveBlocksPerMultiprocessor(&per_cu, (const void*)hybrid_fwd, NTHREADS, LDS_BYTES) != hipSuccess || per_cu < 1) { fprintf(stderr, "kernel_launch: occupancy query says %d blocks per CU\n", per_cu); }
        (void)hipGetLastError();
#else
        ok = ok && hipFuncSetAttribute((const void*)k_p0a, hipFuncAttributeMaxDynamicSharedMemorySize, LDS_BYTES) == hipSuccess;
        ok = ok && hipFuncSetAttribute((const void*)k_layer<0>, hipFuncAttributeMaxDynamicSharedMemorySize, LDS_BYTES) == hipSuccess;
        ok = ok && hipFuncSetAttribute((const void*)k_layer<1>, hipFuncAttributeMaxDynamicSharedMemorySize, LDS_BYTES) == hipSuccess;
        ok = ok && hipFuncSetAttribute((const void*)k_layer<2>, hipFuncAttributeMaxDynamicSharedMemorySize, LDS_BYTES) == hipSuccess;
        ok = ok && hipFuncSetAttribute((const void*)k_layer<3>, hipFuncAttributeMaxDynamicSharedMemorySize, LDS_BYTES) == hipSuccess;
        ok = ok && hipFuncSetAttribute((const void*)k_layer<4>, hipFuncAttributeMaxDynamicSharedMemorySize, LDS_BYTES) == hipSuccess;
#endif
        if (!ok || cus < 1) { fprintf(stderr, "kernel_launch: device set-up failed\n"); grid = -1; return; }
        grid = cus;
    }
    if (grid < 0) return;
    Params p{};
    p.x = (const float*)d_in[0]; p.c = (const float*)d_in[1]; p.pos = (const int*)d_in[2]; p.w_mod = (const float*)d_in[3]; p.b_mod = (const float*)d_in[4]; p.g_norm = (const float*)d_in[5];
    p.w_in = (const float*)d_in[6]; p.g_cq = (const float*)d_in[7]; p.g_ckv = (const float*)d_in[8]; p.w_uq = (const float*)d_in[9]; p.w_ukv = (const float*)d_in[10];
    p.w_ret = (const float*)d_in[11]; p.w_mla = (const float*)d_in[12]; p.w_out = (const float*)d_in[13]; p.g_final = (const float*)d_in[14];
    p.out = (float*)d_out; p.ws = (unsigned char*)d_ws;
    for (int j = 0; j < 64; ++j) p.inv_r[j] = (float)(1.0 / pow(10000.0, (double)(2 * j) / 128.0));
    for (int j = 0; j < 32; ++j) p.inv_m[j] = (float)(1.0 / pow(10000.0, (double)(2 * j) / 64.0));
#if MK_COOP
    p.ph_lo = 0; p.ph_hi = N_PHASES;
    void* args[] = {&p};
    hipError_t e = hipLaunchCooperativeKernel((const void*)hybrid_fwd, dim3(grid), dim3(NTHREADS), args, LDS_BYTES, stream);
    if (e != hipSuccess) fprintf(stderr, "kernel_launch: cooperative launch failed: %s (grid %d)\n", hipGetErrorString(e), grid);
#else
    p.ph_lo = 0; p.ph_hi = 0;
    hipLaunchKernelGGL(k_p0a, dim3(grid), dim3(NTHREADS), LDS_BYTES, stream, p);
    hipLaunchKernelGGL(k_p0b, dim3(grid), dim3(NTHREADS), 0, stream, p);
    for (int l = 0; l < DEPTH; ++l) { p.ph_lo = l;
        hipLaunchKernelGGL(k_layer<0>, dim3(grid), dim3(NTHREADS), LDS_BYTES, stream, p);
        hipLaunchKernelGGL(k_layer<1>, dim3(grid), dim3(NTHREADS), LDS_BYTES, stream, p);
        hipLaunchKernelGGL(k_layer<2>, dim3(grid), dim3(NTHREADS), LDS_BYTES, stream, p);
        hipLaunchKernelGGL(k_layer<3>, dim3(grid), dim3(NTHREADS), LDS_BYTES, stream, p);
        hipLaunchKernelGGL(k_layer<4>, dim3(grid), dim3(NTHREADS), LDS_BYTES, stream, p); }
    hipLaunchKernelGGL(k_final, dim3(grid), dim3(NTHREADS), 0, stream, p);
#endif
}
```

```cpp
#include <hip/hip_runtime.h>
#include <hip/hip_cooperative_groups.h>
#include <cstdio>
#include <cmath>
#include <cstdint>
namespace cg = cooperative_groups;

#ifndef MK_COOP
#define MK_COOP 1
#endif

constexpr int T_TOK = 16384, DM = 2048, NBATCH = 4, SEQ = 4096, DEPTH = 4;
constexpr int DIN = 13376, DINP = 13568;
constexpr int NQ = 3072, NKV = 4096;
constexpr float EPS = 1e-6f;
constexpr int NTHREADS = 512;
constexpr int LDS_GEMM = 131072, LDS_BYTES = LDS_GEMM + 64;

typedef unsigned short bf16_t;
typedef short bf16x8 __attribute__((ext_vector_type(8)));
typedef short s16x4 __attribute__((ext_vector_type(4)));
typedef float f32x4 __attribute__((ext_vector_type(4)));
typedef float f32x2 __attribute__((ext_vector_type(2)));
typedef float f32x16 __attribute__((ext_vector_type(16)));
typedef unsigned u32x4 __attribute__((ext_vector_type(4)));
typedef unsigned u32x2 __attribute__((ext_vector_type(2)));

typedef __bf16 bf16x2_t __attribute__((ext_vector_type(2)));
__device__ __forceinline__ unsigned cvt_pk_bf16(float lo, float hi) { f32x2 v = {lo, hi}; bf16x2_t r = __builtin_convertvector(v, bf16x2_t); return __builtin_bit_cast(unsigned, r); }
__device__ __forceinline__ int tid_opaque() { int t = threadIdx.x; asm volatile("" : "+v"(t)); return t; }
__device__ __forceinline__ int lane_opaque() { int l; asm volatile("v_mbcnt_lo_u32_b32 %0, -1, 0\n\tv_mbcnt_hi_u32_b32 %0, -1, %0" : "=v"(l)); return l; }
__device__ __forceinline__ float xadd32(float x) { auto r = __builtin_amdgcn_permlane32_swap(__float_as_uint(x), __float_as_uint(x), false, false); return __uint_as_float(r[0]) + __uint_as_float(r[1]); }
__device__ __forceinline__ float xadd16(float x) { auto r = __builtin_amdgcn_permlane16_swap(__float_as_uint(x), __float_as_uint(x), false, false); return __uint_as_float(r[0]) + __uint_as_float(r[1]); }
__device__ __forceinline__ float bf_lo(unsigned w) { return __uint_as_float(w << 16); }
__device__ __forceinline__ float bf_hi(unsigned w) { return __uint_as_float(w & 0xffff0000u); }
__device__ __forceinline__ float bf2f(bf16_t v) { return __uint_as_float(((unsigned)v) << 16); }
__device__ __forceinline__ bf16_t f2bf(float f) { return (bf16_t)(cvt_pk_bf16(f, 0.f) & 0xffffu); }
__device__ __forceinline__ float silu_f(float x) { return x * __builtin_amdgcn_rcpf(1.0f + __expf(-x)); }
__device__ __forceinline__ float sigmoid_f(float x) { return __builtin_amdgcn_rcpf(1.0f + __expf(-x)); }

constexpr size_t al256(size_t x) { return (x + 255) / 256 * 256; }
constexpr size_t SZ_WT_IN = (size_t)DINP * DM * 2, SZ_WT_Q = (size_t)NQ * 512 * 2, SZ_WT_KV = (size_t)NKV * 512 * 2, SZ_WT_RM = (size_t)DM * 4096 * 2, SZ_WT_O = (size_t)DM * DM * 2;
constexpr size_t WS_WT_IN = 0;
constexpr size_t WS_WT_Q = WS_WT_IN + DEPTH * SZ_WT_IN;
constexpr size_t WS_WT_KV = WS_WT_Q + DEPTH * SZ_WT_Q;
constexpr size_t WS_WT_RM = WS_WT_KV + DEPTH * SZ_WT_KV;
constexpr size_t WS_WT_O = WS_WT_RM + DEPTH * SZ_WT_RM;
constexpr size_t WS_MOD = WS_WT_O + DEPTH * SZ_WT_O;
constexpr size_t WS_BIAS2 = WS_MOD + al256((size_t)DEPTH * 4 * 6144 * 4);
constexpr size_t WS_COSR = WS_BIAS2 + al256((size_t)DEPTH * 4 * DINP * 4);
constexpr size_t WS_SINR = WS_COSR + (size_t)T_TOK * 64 * 4;
constexpr size_t WS_COSM = WS_SINR + (size_t)T_TOK * 64 * 4;
constexpr size_t WS_SINM = WS_COSM + (size_t)T_TOK * 32 * 4;
constexpr size_t WS_SSQX = WS_SINM + (size_t)T_TOK * 32 * 4;
constexpr size_t WS_SSQC = WS_SSQX + (size_t)T_TOK * 32 * 4;
constexpr size_t WS_CTR = WS_SSQC + (size_t)T_TOK * 16 * 4;
constexpr size_t WS_XG = WS_CTR + 256;
constexpr size_t WS_RQ = WS_XG + (size_t)T_TOK * 2048 * 2;
constexpr size_t WS_RK = WS_RQ + (size_t)T_TOK * 1024 * 2;
constexpr size_t WS_RV = WS_RK + (size_t)T_TOK * 1024 * 2;
constexpr size_t WS_SRG = WS_RV + (size_t)T_TOK * 2048 * 2;
constexpr size_t WS_SMG = WS_SRG + (size_t)T_TOK * 2048 * 2;
constexpr size_t WS_CQ = WS_SMG + (size_t)T_TOK * 2048 * 2;
constexpr size_t WS_CKV = WS_CQ + (size_t)T_TOK * 512 * 2;
constexpr size_t WS_GATE = WS_CKV + (size_t)T_TOK * 512 * 2;
constexpr size_t WS_QB = WS_GATE + (size_t)T_TOK * 4096 * 2;
constexpr size_t WS_KB = WS_QB + (size_t)T_TOK * 3072 * 2;
constexpr size_t WS_VB = WS_KB + (size_t)T_TOK * 3072 * 2;
constexpr size_t WS_AR = WS_VB + (size_t)T_TOK * 2048 * 2;
#if defined(MK_DEBUG)
constexpr size_t WS_MERGED = WS_AR + (size_t)T_TOK * 4096 * 2;
constexpr size_t WS_END = WS_MERGED + (size_t)T_TOK * 2048 * 2;
#else
constexpr size_t WS_MERGED = WS_RQ;
constexpr size_t WS_END = WS_AR + (size_t)T_TOK * 4096 * 2;
#endif
constexpr size_t WS_XBAR = WS_END + 65536;
constexpr size_t WS_TOTAL = WS_XBAR + 16384;

struct Params {
    const float* x; const float* c; const int* pos; const float* w_mod; const float* b_mod; const float* g_norm; const float* w_in; const float* g_cq; const float* g_ckv;
    const float* w_uq; const float* w_ukv; const float* w_ret; const float* w_mla; const float* w_out; const float* g_final;
    float* out; unsigned char* ws; int ph_lo, ph_hi;
    float inv_r[64]; float inv_m[32];
};

namespace pg8 {
#define PG8_LAS __attribute__((address_space(3)))
constexpr int BM = 256, BK = 64, HALF = 128, HTB = HALF * BK * 2  , STAGE_BYTES = 8 * HTB, NXCD = 8, WGM = 8;
__host__ __device__ __forceinline__ int lds_byte(int r, int c) { const int st = (r >> 4) * 2 + (c >> 5), rr = r & 15, cc = c & 31, ob = rr * 64 + cc * 2; return st * 1024 + (ob ^ (((ob >> 9) & 1) << 5)); }
__host__ __device__ __forceinline__ void stage_rc(int b, int& R, int& C) { const int st = b / 1024, sb = b % 1024, swz = sb ^ (((sb >> 9) & 1) << 5); R = (st >> 1) * 16 + swz / 64; C = (st & 1) * 32 + (swz % 64) / 2; }
__host__ __device__ __forceinline__ int perm32(int rho) { const int n = rho >> 4, i = rho & 15; return 8 * (i >> 2) + 4 * n + (i & 3); }

struct Unit { int pm, pn; };
struct Gemm { const bf16_t* A; const bf16_t* Bt; int M, N, K; };

struct StaticOrder {
    int nM, nN, nwg, G, c;
    __host__ __device__ void init(int M, int N, int G_, int c_) { nM = M / BM; nN = N / BM; nwg = nM * nN; G = G_; c = c_; }
    __host__ __device__ bool next(int i, Unit& u) const {
        const long L = (long)i * G + c; if (L >= nwg) return false;
        int wgid = (int)L; { const int q = nwg / NXCD, r = nwg % NXCD, xcd = wgid % NXCD, off = wgid / NXCD; wgid = (xcd < r ? xcd * (q + 1) : r * (q + 1) + (xcd - r) * q) + off; }
        const int nig = WGM * nN, gid = wgid / nig, fm = gid * WGM, gsz = (nM - fm) < WGM ? (nM - fm) : WGM;
        u.pm = fm + ((wgid % nig) % gsz); u.pn = (wgid % nig) / gsz; return true;
    }
    __device__ __forceinline__ void a_ready(const Unit&) const {}
    __device__ __forceinline__ void done(const Unit&) const {}
};

template <class Epi, class Sched>
__device__ __forceinline__ void gemm_phase(PG8_LAS unsigned char* lds, const Gemm g, const Sched& S, const Epi& E) {
    const int tid = tid_opaque(), wid = __builtin_amdgcn_readfirstlane(tid >> 6), lane = tid & 63, wr = wid >> 2, wc = wid & 3, fr = lane & 15, fq = lane >> 4;
    const int K = g.K, nt = K / BK;
    unsigned voffA[2], voffB[2];
#pragma unroll
    for (int i = 0; i < 2; ++i) { int R, C; stage_rc(tid * 16 + i * 8192, R, C); const int Rb = Epi::PERM ? ((R & ~31) + perm32(R & 31)) : R;
        voffA[i] = (unsigned)(R * K + C) * 2u; voffB[i] = (unsigned)(Rb * K + C) * 2u; }
    const size_t kstep = (size_t)(BK * 2);
    const size_t hstep = (size_t)HALF * K * 2;
    const size_t tstep = 2 * hstep;
    const unsigned ldsw = (unsigned)wid * 1024u;
    const int aoff = lds_byte(wr * 64 + fr, fq * 8), boff = lds_byte(wc * 32 + fr, fq * 8);
#define PG8_SA(b, h) (((b) * 2 + (h)) * HTB)
#define PG8_SB(b, h) ((4 + (b) * 2 + (h)) * HTB)
#define PG8_STAGE(bufoff, gbase, voff) do { _Pragma("unroll") for (int _i = 0; _i < 2; ++_i) \
        __builtin_amdgcn_global_load_lds((const unsigned*)((const char*)(gbase) + (voff)[_i]), (PG8_LAS unsigned*)(lds + (bufoff) + ldsw + _i * 8192), 16, 0, 0); } while (0)
#define PG8_LDA(dst, b, h) do { _Pragma("unroll") for (int m = 0; m < 4; ++m) _Pragma("unroll") for (int k = 0; k < 2; ++k) dst[m][k] = *(const PG8_LAS bf16x8*)(lds + PG8_SA(b, h) + aoff + m * 2048 + k * 1024); } while (0)
#define PG8_LDB(dst, b, h) do { _Pragma("unroll") for (int n = 0; n < 2; ++n) _Pragma("unroll") for (int k = 0; k < 2; ++k) dst[n][k] = *(const PG8_LAS bf16x8*)(lds + PG8_SB(b, h) + boff + n * 2048 + k * 1024); } while (0)
#define PG8_MMA(ai, bj, At, Bt) do { __builtin_amdgcn_s_setprio(1); _Pragma("unroll") for (int m = 0; m < 4; ++m) _Pragma("unroll") for (int n = 0; n < 2; ++n) _Pragma("unroll") for (int k = 0; k < 2; ++k) \
        acc[ai][bj][m][n] = __builtin_amdgcn_mfma_f32_16x16x32_bf16(Bt[n][k], At[m][k], acc[ai][bj][m][n], 0, 0, 0); __builtin_amdgcn_s_setprio(0); } while (0)
#define PG8_WAIT_V(n) asm volatile("s_waitcnt vmcnt(" #n ")" ::: "memory")
#define PG8_WAIT_L(n) asm volatile("s_waitcnt lgkmcnt(" #n ")" ::: "memory")
#define PG8_BAR __builtin_amdgcn_s_barrier()
#define PG8_SCHED __builtin_amdgcn_sched_barrier(0)
    Unit cur, nxt; int ui = 0;
    if (!S.next(0, cur)) return;
    f32x4 acc[2][2][4][2];
#pragma unroll
    for (int a = 0; a < 2; ++a)
#pragma unroll
        for (int b = 0; b < 2; ++b)
#pragma unroll
            for (int m = 0; m < 4; ++m)
#pragma unroll
                for (int n = 0; n < 2; ++n) acc[a][b][m][n] = (f32x4){0.f, 0.f, 0.f, 0.f};
    bf16x8 At[4][2], B0[2][2], B1[2][2];
    const char* cA = (const char*)g.A + (size_t)cur.pm * tstep; const char* cB = (const char*)g.Bt + (size_t)cur.pn * tstep;
    S.a_ready(cur);
    PG8_STAGE(PG8_SB(0, 0), cB, voffB); PG8_STAGE(PG8_SB(0, 1), cB + hstep, voffB); PG8_STAGE(PG8_SA(0, 0), cA, voffA); PG8_STAGE(PG8_SA(0, 1), cA + hstep, voffA);
    if (wr == 1) PG8_BAR;
    PG8_WAIT_V(2); PG8_BAR;
    PG8_STAGE(PG8_SB(1, 0), cB + kstep, voffB); PG8_STAGE(PG8_SA(1, 0), cA + kstep, voffA); PG8_STAGE(PG8_SB(1, 1), cB + hstep + kstep, voffB);
    PG8_WAIT_V(6); PG8_BAR;
    for (;;) {
        const bool has_next = S.next(ui + 1, nxt);
        const char* nA = has_next ? (const char*)g.A + (size_t)nxt.pm * tstep : cA; const char* nB = has_next ? (const char*)g.Bt + (size_t)nxt.pn * tstep : cB;
        for (int t = 0; t < nt; t += 2) {
            const bool last = (t == nt - 2);
            const char* a1 = cA + (size_t)(t + 1) * kstep;
            const char* a2 = last ? nA : cA + (size_t)(t + 2) * kstep; const char* b2 = last ? nB : cB + (size_t)(t + 2) * kstep;
            const char* a3 = a2 + kstep; const char* b3 = b2 + kstep;
            if constexpr (Epi::HAS_MID) { if (t == (nt >> 1)) { if (wr == 0) PG8_BAR; E.mid(acc, cur, wr, wc, fr, fq); if (wr == 1) PG8_BAR; } }
            if (last && has_next) S.a_ready(nxt);
            PG8_LDB(B0, 0, 0); PG8_LDB(B1, 0, 1); PG8_SCHED; PG8_LDA(At, 0, 0); PG8_STAGE(PG8_SA(1, 1), a1 + hstep, voffA);
            PG8_WAIT_V(8); PG8_WAIT_L(0); PG8_BAR; PG8_MMA(0, 0, At, B0); PG8_MMA(0, 1, At, B1); PG8_BAR; PG8_SCHED;
            PG8_LDA(At, 0, 1); PG8_STAGE(PG8_SB(0, 0), b2, voffB); PG8_STAGE(PG8_SB(0, 1), b2 + hstep, voffB); PG8_STAGE(PG8_SA(0, 0), a2, voffA);
            PG8_WAIT_V(8); PG8_WAIT_L(0); PG8_BAR; PG8_MMA(1, 0, At, B0); PG8_MMA(1, 1, At, B1); PG8_BAR; PG8_SCHED;
            PG8_LDB(B0, 1, 0); PG8_LDB(B1, 1, 1); PG8_SCHED; PG8_LDA(At, 1, 0); PG8_STAGE(PG8_SA(0, 1), a2 + hstep, voffA);
            PG8_WAIT_V(8); PG8_WAIT_L(0); PG8_BAR; PG8_MMA(0, 0, At, B0); PG8_MMA(0, 1, At, B1); PG8_BAR; PG8_SCHED;
            PG8_LDA(At, 1, 1); PG8_STAGE(PG8_SB(1, 0), b3, voffB); PG8_STAGE(PG8_SB(1, 1), b3 + hstep, voffB); PG8_STAGE(PG8_SA(1, 0), a3, voffA);
            PG8_WAIT_V(8); PG8_WAIT_L(0); PG8_BAR; PG8_MMA(1, 0, At, B0); PG8_MMA(1, 1, At, B1); PG8_BAR; PG8_SCHED;
        }
        if (wr == 0) PG8_BAR;
        E(acc, cur, wr, wc, fr, fq); S.done(cur);
        if (!has_next) break;
#pragma unroll
        for (int a = 0; a < 2; ++a)
#pragma unroll
            for (int b = 0; b < 2; ++b)
#pragma unroll
                for (int m = 0; m < 4; ++m)
#pragma unroll
                    for (int n = 0; n < 2; ++n) acc[a][b][m][n] = (f32x4){0.f, 0.f, 0.f, 0.f};
        cur = nxt; cA = nA; cB = nB; ++ui;
        if (wr == 1) PG8_BAR;
    }
    PG8_WAIT_V(0);
    PG8_BAR;
#undef PG8_SA
#undef PG8_SB
#undef PG8_STAGE
#undef PG8_LDA
#undef PG8_LDB
#undef PG8_MMA
#undef PG8_WAIT_V
#undef PG8_WAIT_L
#undef PG8_BAR
#undef PG8_SCHED
}
}

using pg8::Unit;
typedef const f32x4 (&AccC)[2][2][4][2];
typedef f32x4 (&AccM)[2][2][4][2];

__device__ __forceinline__ void st8(bf16_t* p, const float (&v)[8]) {
    u32x4 w; w.x = cvt_pk_bf16(v[0], v[1]); w.y = cvt_pk_bf16(v[2], v[3]); w.z = cvt_pk_bf16(v[4], v[5]); w.w = cvt_pk_bf16(v[6], v[7]); *(u32x4*)p = w;
}
__device__ __forceinline__ void rope8(float (&v)[8], const float* cp, const float* sp) {
    const f32x4 c = *(const f32x4*)cp, s = *(const f32x4*)sp;
#pragma unroll
    for (int q = 0; q < 4; ++q) { const float x1 = v[2 * q], x2 = v[2 * q + 1]; v[2 * q] = x1 * c[q] - x2 * s[q]; v[2 * q + 1] = x1 * s[q] + x2 * c[q]; }
}

__device__ __forceinline__ void rope8v(float (&v)[8], const f32x4 c, const f32x4 s) {
#pragma unroll
    for (int q = 0; q < 4; ++q) { const float x1 = v[2 * q], x2 = v[2 * q + 1]; v[2 * q] = x1 * c[q] - x2 * s[q]; v[2 * q + 1] = x1 * s[q] + x2 * c[q]; }
}
struct EpiIn {
    static constexpr bool PERM = true, HAS_MID = false;
    const float* ssqx; const float* bias2; const float* cos_r; const float* sin_r; const float* cos_m; const float* sin_m;
    bf16_t *RQ, *RK, *RV, *SRG, *CQ, *CKV, *SMG, *GATE, *KB; float* ssqc;
    __device__ __forceinline__ void mid(AccM, const Unit&, int, int, int, int) const {}
    template <int MODE> __device__ __forceinline__ void body(AccC acc, const Unit& u, int wr, int wc, int fr, int fq) const {
        const int pn = u.pn, row0 = u.pm * 256 + wr * 64 + fr, b = u.pm >> 4, cl = wc * 32 + 8 * fq;
        float rinv[2][4];
#pragma unroll
        for (int ai = 0; ai < 2; ++ai)
#pragma unroll
            for (int m = 0; m < 4; ++m) { const float* sp = ssqx + (size_t)(row0 + ai * 128 + m * 16) * 32 + fq * 8; const f32x4 a = *(const f32x4*)sp, c = *(const f32x4*)(sp + 4);
                float s = ((a[0] + a[1]) + (a[2] + a[3])) + ((c[0] + c[1]) + (c[2] + c[3])); s = xadd16(s); s = xadd32(s); rinv[ai][m] = rsqrtf(s * (1.0f / 2048.0f) + EPS); }
        f32x4 bz[2][2];
#pragma unroll
        for (int bj = 0; bj < 2; ++bj) { const float* bp = bias2 + (size_t)b * DINP + pn * 256 + bj * 128 + cl; bz[bj][0] = *(const f32x4*)bp; bz[bj][1] = *(const f32x4*)(bp + 4); }
#pragma unroll
        for (int ai = 0; ai < 2; ++ai) {
            f32x4 rc[4], rs[4];
#pragma unroll
            for (int m = 0; m < 4; ++m) {
              if ((MODE == 0 || MODE == 5) && (m & 1) == 0) {
#pragma unroll
                for (int m2 = m; m2 < m + 2; ++m2) { const int m_ = m2; const size_t ro = (size_t)(row0 + ai * 128 + m_ * 16); rc[m_] = MODE == 0 ? *(const f32x4*)(cos_r + ro * 64 + (cl >> 1)) : *(const f32x4*)(cos_m + ro * 32 + ((cl & 63) >> 1));
                    rs[m_] = MODE == 0 ? *(const f32x4*)(sin_r + ro * 64 + (cl >> 1)) : *(const f32x4*)(sin_m + ro * 32 + ((cl & 63) >> 1)); }
              }
                const int row = row0 + ai * 128 + m * 16; const float r = rinv[ai][m];
                float ssq = 0.f;
#pragma unroll
                for (int bj = 0; bj < 2; ++bj) {
                    if (MODE == 5 && (bj != 0 || wc >= 2)) continue;
                    const int col = pn * 256 + bj * 128 + cl;
                    const f32x4 a0 = acc[ai][bj][m][0] * r + bz[bj][0], a1 = acc[ai][bj][m][1] * r + bz[bj][1];
                    float v[8] = {a0[0], a0[1], a0[2], a0[3], a1[0], a1[1], a1[2], a1[3]};
                    if (MODE == 0) {
                        rope8v(v, rc[m], rs[m]);
                        if (pn >= 4) {
#pragma unroll
                            for (int i = 0; i < 8; ++i) v[i] *= 0.08838834764831845f;
                        }
                        bf16_t* dst = (pn < 4 ? RQ : RK) + (size_t)row * 1024 + (pn & 3) * 256 + bj * 128 + cl; st8(dst, v);
                    } else if (MODE == 1) {
                        st8(RV + (size_t)row * 2048 + (col - 2048), v);
                    } else if (MODE == 2) {
#pragma unroll
                        for (int i = 0; i < 8; ++i) v[i] = silu_f(v[i]);
                        bf16_t* dst = (pn < 24) ? SRG + (size_t)row * 2048 + (col - 4096) : SMG + (size_t)row * 2048 + (col - 7168); st8(dst, v);
                    } else if (MODE == 3) {
#pragma unroll
                        for (int i = 0; i < 8; ++i) v[i] = sigmoid_f(v[i]);
                        st8(GATE + (size_t)row * 4096 + (col - 9216), v);
                    } else if (MODE == 4) {
#pragma unroll
                        for (int i = 0; i < 8; ++i) ssq += v[i] * v[i];
                        asm volatile("" : "+v"(ssq));
                        bf16_t* dst = (pn < 26) ? CQ + (size_t)row * 512 + (col - 6144) : CKV + (size_t)row * 512 + (col - 6656); st8(dst, v);
                    } else {
                        rope8v(v, rc[m], rs[m]);
                        bf16_t* dst = KB + (size_t)row * 3072 + 128 + cl;
                        u32x4 w; w.x = cvt_pk_bf16(v[0], v[1]); w.y = cvt_pk_bf16(v[2], v[3]); w.z = cvt_pk_bf16(v[4], v[5]); w.w = cvt_pk_bf16(v[6], v[7]);
#pragma unroll 1
                        for (int h = 0; h < 16; ++h) { *(u32x4*)dst = w; dst += 192; }
                    }
                }
                if (MODE == 4) { ssq = xadd16(ssq); ssq = xadd32(ssq); if (fq == 0) ssqc[(size_t)row * 16 + (pn - 24) * 4 + wc] = ssq; }
                asm volatile("" ::: "memory");
            }
        }
    }
    __device__ __forceinline__ void operator()(AccC acc, const Unit& u, int wr, int wc, int fr, int fq) const {
        { const int l_ = lane_opaque(); fr = l_ & 15; fq = l_ >> 4; }
        const int pn = u.pn;
        if (pn < 8) body<0>(acc, u, wr, wc, fr, fq);
        else if (pn < 16) body<1>(acc, u, wr, wc, fr, fq);
        else if (pn < 24) body<2>(acc, u, wr, wc, fr, fq);
        else if (pn < 28) body<4>(acc, u, wr, wc, fr, fq);
        else if (pn < 36) body<2>(acc, u, wr, wc, fr, fq);
        else if (pn < 52) body<3>(acc, u, wr, wc, fr, fq);
        else body<5>(acc, u, wr, wc, fr, fq);
    }
};

template <int KV> struct EpiUp {
    static constexpr bool PERM = true, HAS_MID = false;
    const float* ssqc; const float* cos_m; const float* sin_m; bf16_t* QB; bf16_t* KB; bf16_t* VB;
    __device__ __forceinline__ void mid(AccM, const Unit&, int, int, int, int) const {}
    __device__ __forceinline__ void operator()(AccC acc, const Unit& u, int wr, int wc, int fr, int fq) const {
        { const int l_ = lane_opaque(); fr = l_ & 15; fq = l_ >> 4; }
        const int pn = u.pn, row0 = u.pm * 256 + wr * 64 + fr, cl = wc * 32 + 8 * fq;
        float rinv[2][4];
#pragma unroll
        for (int ai = 0; ai < 2; ++ai)
#pragma unroll
            for (int m = 0; m < 4; ++m) { const float* sp = ssqc + (size_t)(row0 + ai * 128 + m * 16) * 16 + KV * 8; const f32x4 a = *(const f32x4*)sp, c = *(const f32x4*)(sp + 4);
                const float s = ((a[0] + a[1]) + (a[2] + a[3])) + ((c[0] + c[1]) + (c[2] + c[3])); rinv[ai][m] = rsqrtf(s * (1.0f / 512.0f) + EPS); }
#pragma unroll
        for (int bj = 0; bj < 2; ++bj)
#pragma unroll
            for (int ai = 0; ai < 2; ++ai)
#pragma unroll
                for (int m = 0; m < 4; ++m) {
                    const int row = row0 + ai * 128 + m * 16; const float r = rinv[ai][m];
                    const f32x4 a0 = acc[ai][bj][m][0] * r, a1 = acc[ai][bj][m][1] * r;
                    float v[8] = {a0[0], a0[1], a0[2], a0[3], a1[0], a1[1], a1[2], a1[3]};
                    if (KV == 0) {
                        if (pn < 8) { st8(QB + (size_t)row * 3072 + (pn * 2 + bj) * 192 + cl, v); }
                        else { const int rr = (pn - 8) * 256 + bj * 128 + cl, h = rr >> 6, p = rr & 63;
                            rope8(v, cos_m + (size_t)row * 32 + (p >> 1), sin_m + (size_t)row * 32 + (p >> 1));
                            st8(QB + (size_t)row * 3072 + h * 192 + 128 + p, v); }
                    } else {
                        if (pn < 8) st8(KB + (size_t)row * 3072 + (pn * 2 + bj) * 192 + cl, v);
                        else st8(VB + (size_t)row * 2048 + (pn - 8) * 256 + bj * 128 + cl, v);
                    }
                    asm volatile("" ::: "memory");
                }
    }
};

struct EpiMerge {
    static constexpr bool PERM = true, HAS_MID = true;
    const bf16_t* GATE; bf16_t* MERGED;
    __device__ __forceinline__ void mid(AccM acc, const Unit& u, int wr, int wc, int fr, int fq) const {
        { const int l_ = lane_opaque(); fr = l_ & 15; fq = l_ >> 4; }
        const int row0 = u.pm * 256 + wr * 64 + fr, cl = wc * 32 + 8 * fq;
#pragma unroll
        for (int ai = 0; ai < 2; ++ai)
#pragma unroll
            for (int mp = 0; mp < 2; ++mp) {
                u32x4 ga[2][2], gb[2][2];
#pragma unroll
                for (int mm = 0; mm < 2; ++mm)
#pragma unroll
                    for (int bj = 0; bj < 2; ++bj) { const bf16_t* gp = GATE + (size_t)(row0 + ai * 128 + (2 * mp + mm) * 16) * 4096 + u.pn * 256 + bj * 128 + cl; ga[mm][bj] = *(const u32x4*)gp; gb[mm][bj] = *(const u32x4*)(gp + 2048); }
#pragma unroll
                for (int mm = 0; mm < 2; ++mm)
#pragma unroll
                    for (int bj = 0; bj < 2; ++bj) { const int m = 2 * mp + mm; const u32x4 a = ga[mm][bj], b = gb[mm][bj]; f32x4 r0, r1;
                        r0[0] = bf_lo(a.x) * __builtin_amdgcn_rcpf(bf_lo(b.x)); r0[1] = bf_hi(a.x) * __builtin_amdgcn_rcpf(bf_hi(b.x));
                        r0[2] = bf_lo(a.y) * __builtin_amdgcn_rcpf(bf_lo(b.y)); r0[3] = bf_hi(a.y) * __builtin_amdgcn_rcpf(bf_hi(b.y));
                        r1[0] = bf_lo(a.z) * __builtin_amdgcn_rcpf(bf_lo(b.z)); r1[1] = bf_hi(a.z) * __builtin_amdgcn_rcpf(bf_hi(b.z));
                        r1[2] = bf_lo(a.w) * __builtin_amdgcn_rcpf(bf_lo(b.w)); r1[3] = bf_hi(a.w) * __builtin_amdgcn_rcpf(bf_hi(b.w));
                        acc[ai][bj][m][0] *= r0; acc[ai][bj][m][1] *= r1; }
                asm volatile("" ::: "memory");
            }
    }
    __device__ __forceinline__ void operator()(AccC acc, const Unit& u, int wr, int wc, int fr, int fq) const {
        { const int l_ = lane_opaque(); fr = l_ & 15; fq = l_ >> 4; }
        const int row0 = u.pm * 256 + wr * 64 + fr, cl = wc * 32 + 8 * fq;
#pragma unroll
        for (int ai = 0; ai < 2; ++ai)
#pragma unroll
            for (int m = 0; m < 4; ++m) {
#pragma unroll
                for (int bj = 0; bj < 2; ++bj) {
                    const size_t off = (size_t)(row0 + ai * 128 + m * 16);
                    const int col = u.pn * 256 + bj * 128 + cl;
                    const u32x4 gb = *(const u32x4*)(GATE + off * 4096 + 2048 + col);
                    const f32x4 a0 = acc[ai][bj][m][0], a1 = acc[ai][bj][m][1];
                    float v[8] = {a0[0] * bf_lo(gb.x), a0[1] * bf_hi(gb.x), a0[2] * bf_lo(gb.y), a0[3] * bf_hi(gb.y), a1[0] * bf_lo(gb.z), a1[1] * bf_hi(gb.z), a1[2] * bf_lo(gb.w), a1[3] * bf_hi(gb.w)};
                    st8(MERGED + off * 2048 + col, v);
                    asm volatile("" ::: "memory");
                }
            }
    }
};

struct EpiOut {
    static constexpr bool PERM = false, HAS_MID = false;
    const float* xin; float* xout; const float* gate;   const float* gnorm_next; const float* scale_next;
    bf16_t* XG; float* ssqx;
    __device__ __forceinline__ void mid(AccM, const Unit&, int, int, int, int) const {}
    __device__ __forceinline__ void operator()(AccC acc, const Unit& u, int wr, int wc, int fr, int fq) const {
        { const int l_ = lane_opaque(); fr = l_ & 15; fq = l_ >> 4; }
        const int row0 = u.pm * 256 + wr * 64 + fr, b = u.pm >> 4, col0 = u.pn * 256 + wc * 32 + 4 * fq;
        f32x4 gt[2][2], gn[2][2];
#pragma unroll
        for (int bj = 0; bj < 2; ++bj)
#pragma unroll
            for (int n = 0; n < 2; ++n) { const int col = col0 + bj * 128 + n * 16; gt[bj][n] = *(const f32x4*)(gate + (size_t)b * 6144 + col);
                const f32x4 g = *(const f32x4*)(gnorm_next + col), s = *(const f32x4*)(scale_next + (size_t)b * 6144 + col); gn[bj][n] = g * (s + 1.0f); }
#pragma unroll
        for (int ai = 0; ai < 2; ++ai)
#pragma unroll
            for (int m = 0; m < 4; ++m) {
                const int row = row0 + ai * 128 + m * 16; float ss = 0.f; const size_t off0 = (size_t)row * 2048 + col0;
                f32x4 xo[2][2];
#pragma unroll
                for (int bj = 0; bj < 2; ++bj)
#pragma unroll
                    for (int n = 0; n < 2; ++n) xo[bj][n] = *(const f32x4*)(xin + off0 + bj * 128 + n * 16);
#pragma unroll
                for (int bj = 0; bj < 2; ++bj)
#pragma unroll
                    for (int n = 0; n < 2; ++n) { const size_t off = off0 + bj * 128 + n * 16;
                        const f32x4 xn = xo[bj][n] + gt[bj][n] * acc[ai][bj][m][n];
                        *(f32x4*)(xout + off) = xn; ss += (xn[0] * xn[0] + xn[1] * xn[1]) + (xn[2] * xn[2] + xn[3] * xn[3]);
                        const f32x4 y = xn * gn[bj][n]; u32x2 w; w.x = cvt_pk_bf16(y[0], y[1]); w.y = cvt_pk_bf16(y[2], y[3]); *(u32x2*)(XG + off) = w; }
                ss = xadd16(ss); ss = xadd32(ss);
                if (fq == 0) ssqx[(size_t)row * 32 + u.pn * 4 + wc] = ss;
                asm volatile("" ::: "memory");
            }
    }
};

namespace att {
constexpr int KVBLK = 64, QBLK = 32;
constexpr float SCALE = 0.07216878364870322f;
constexpr float THR = 8.f;
constexpr int LDQ = 3072, LDK = 3072, LDV = 2048;
constexpr int SHM_V = KVBLK * 128 * 2, SHM_K = KVBLK * 192 * 2;
#define KSWZ(row, colB) ((row) * 384 + ((colB) ^ (((row) & 7) << 4)))
#define SBAR() __builtin_amdgcn_sched_barrier(0)
__device__ __forceinline__ int crow(int r, int hi) { return (r & 3) + 8 * (r >> 2) + 4 * hi; }

__device__ __forceinline__ void partialSM(f32x16& p0, f32x16& p1, float& m_reg, float& mn, float& alpha) {
  constexpr float C = SCALE * 1.4426950408889634f;
  float pmax = p0[0];
#pragma unroll
  for (int r = 1; r < 16; ++r) pmax = fmaxf(pmax, p0[r]);
#pragma unroll
  for (int r = 0; r < 16; ++r) pmax = fmaxf(pmax, p1[r]);
  { auto rr = __builtin_amdgcn_permlane32_swap(__float_as_uint(pmax), __float_as_uint(pmax), false, false);
    pmax = fmaxf(__uint_as_float(rr[0]), __uint_as_float(rr[1])); }
  if (__builtin_expect(__all(pmax - m_reg <= THR / SCALE), 1)) { mn = m_reg; alpha = 1.f; }
  else { mn = fmaxf(m_reg, pmax); alpha = __builtin_amdgcn_exp2f((m_reg - mn) * C); m_reg = mn; }
  float mnC = -mn * C;
#pragma unroll
  for (int r = 0; r < 16; ++r) p0[r] = fmaf(p0[r], C, mnC);
#pragma unroll
  for (int r = 0; r < 16; ++r) p1[r] = fmaf(p1[r], C, mnC);
#pragma unroll
  for (int r = 0; r < 16; ++r) p0[r] = __builtin_amdgcn_exp2f(p0[r]);
}
__device__ __forceinline__ void finishSM(f32x16& p0, f32x16& p1, float alpha, float& l_reg, bf16x8& pa0, bf16x8& pa1, bf16x8& pa2, bf16x8& pa3) {
#pragma unroll
  for (int r = 0; r < 16; ++r) p1[r] = __builtin_amdgcn_exp2f(p1[r]);
  float ps = 0;
#pragma unroll
  for (int r = 0; r < 16; ++r) ps += p0[r];
#pragma unroll
  for (int r = 0; r < 16; ++r) ps += p1[r];
  { auto rr = __builtin_amdgcn_permlane32_swap(__float_as_uint(ps), __float_as_uint(ps), false, false);
    ps = __uint_as_float(rr[0]) + __uint_as_float(rr[1]); }
  l_reg = l_reg * alpha + ps;
#define PK4(P, BASE, OUT) do { unsigned a0 = cvt_pk_bf16(P[BASE + 0], P[BASE + 1]), a1 = cvt_pk_bf16(P[BASE + 2], P[BASE + 3]);   \
    unsigned b0 = cvt_pk_bf16(P[BASE + 4], P[BASE + 5]), b1 = cvt_pk_bf16(P[BASE + 6], P[BASE + 7]);                              \
    auto r0 = __builtin_amdgcn_permlane32_swap(a0, b0, false, false); auto r1 = __builtin_amdgcn_permlane32_swap(a1, b1, false, false); \
    u32x4 w = {r0[0], r1[0], r0[1], r1[1]}; OUT = *reinterpret_cast<bf16x8*>(&w); } while (0)
  PK4(p0, 0, pa0); PK4(p0, 8, pa1); PK4(p1, 0, pa2); PK4(p1, 8, pa3);
#undef PK4
}
__device__ __forceinline__ void qkt(f32x16& p0, f32x16& p1, const char* Ks, const bf16x8* qr, int r32, int hi) {
  p0 = f32x16{}; p1 = f32x16{};
#pragma unroll
  for (int d0 = 0; d0 < 12; ++d0) { int cb = (d0 * 16 + hi * 8) * 2;
    bf16x8 b0 = *reinterpret_cast<const bf16x8*>(Ks + KSWZ(r32, cb));
    bf16x8 b1 = *reinterpret_cast<const bf16x8*>(Ks + KSWZ(32 + r32, cb));
    p0 = __builtin_amdgcn_mfma_f32_32x32x16_bf16(b0, qr[d0], p0, 0, 0, 0);
    p1 = __builtin_amdgcn_mfma_f32_32x32x16_bf16(b1, qr[d0], p1, 0, 0, 0); }
}
__device__ __forceinline__ int v_st(int k, int c) { const int kk = (k & ~0xC) | ((k & 4) << 1) | ((k & 8) >> 1); return ((kk >> 3) * 4 + (c >> 5)) * 512 + ((kk & 7) * 32 + (c & 31)) * 2; }
__device__ __forceinline__ int v_rd_base(int lane) { return ((lane & 3) << 3) | (((lane >> 2) & 3) << 6) | (((lane >> 4) & 1) << 5) | (((lane >> 5) & 1) << 8); }
constexpr int v_rd_off(int d0, int ks, int half) { return d0 * 512 + ks * 4096 + half * 2048; }
template <int OFF> __device__ __forceinline__ s16x4 tr_read(int vb) {
  s16x4 r; asm volatile("ds_read_b64_tr_b16 %0, %1 offset:%2" : "=&v"(r) : "v"(vb), "i"(OFF) : "memory"); return r;
}
template <int D0> __device__ __forceinline__ void pv_one(f32x16& od, int vb, bf16x8 pa0, bf16x8 pa1, bf16x8 pa2, bf16x8 pa3) {
  const s16x4 l0 = tr_read<v_rd_off(D0, 0, 0)>(vb), h0 = tr_read<v_rd_off(D0, 0, 1)>(vb), l1 = tr_read<v_rd_off(D0, 1, 0)>(vb), h1 = tr_read<v_rd_off(D0, 1, 1)>(vb);
  const s16x4 l2 = tr_read<v_rd_off(D0, 2, 0)>(vb), h2 = tr_read<v_rd_off(D0, 2, 1)>(vb), l3 = tr_read<v_rd_off(D0, 3, 0)>(vb), h3 = tr_read<v_rd_off(D0, 3, 1)>(vb);
  asm volatile("s_waitcnt lgkmcnt(0)" ::: "memory"); SBAR();
#define PK(L, H) (bf16x8){L[0], L[1], L[2], L[3], H[0], H[1], H[2], H[3]}
  od = __builtin_amdgcn_mfma_f32_32x32x16_bf16(pa0, PK(l0, h0), od, 0, 0, 0);
  od = __builtin_amdgcn_mfma_f32_32x32x16_bf16(pa1, PK(l1, h1), od, 0, 0, 0);
  od = __builtin_amdgcn_mfma_f32_32x32x16_bf16(pa2, PK(l2, h2), od, 0, 0, 0);
  od = __builtin_amdgcn_mfma_f32_32x32x16_bf16(pa3, PK(l3, h3), od, 0, 0, 0);
#undef PK
}
__device__ __forceinline__ void pv_d0(f32x16* o, int vb, bf16x8 pa0, bf16x8 pa1, bf16x8 pa2, bf16x8 pa3) {
  pv_one<0>(o[0], vb, pa0, pa1, pa2, pa3); pv_one<1>(o[1], vb, pa0, pa1, pa2, pa3); pv_one<2>(o[2], vb, pa0, pa1, pa2, pa3); pv_one<3>(o[3], vb, pa0, pa1, pa2, pa3);
}

__device__ __forceinline__ void attn_item(const bf16_t* __restrict__ Qb, const bf16_t* __restrict__ Kh, const bf16_t* __restrict__ Vh, bf16_t* __restrict__ Ob, const bf16_t* __restrict__ Gb, int qb, char* lds) {
  const int tid = tid_opaque(), wid = tid >> 6, lane = tid & 63, r32 = lane & 31, hi = lane >> 5;
  char* V_lds = lds; char* K_lds = lds + 2 * SHM_V;
  float* wsl = (float*)(lds + 2 * SHM_V + 2 * SHM_K) + wid * 64; float* li_l = wsl; float* al_l = wsl + 32;
  float m_reg = -1e30f, l_reg = 0; f32x16 o[4] = {}; bf16x8 qr[12];
  const bf16_t* Qw = Qb + (size_t)(wid * QBLK + r32) * LDQ + hi * 8;
#pragma unroll
  for (int d0 = 0; d0 < 12; ++d0) qr[d0] = *reinterpret_cast<const bf16x8*>(Qw + d0 * 16);
  const int sr = tid >> 4, sc = (tid & 15) * 8, vst0 = v_st(sr, sc), vst1 = v_st(32 + sr, sc);
  int kgo[3], klo[3];
#pragma unroll
  for (int i = 0; i < 3; ++i) { const int q = tid + 512 * i, kr_ = q / 24, kc_ = (q % 24) * 8; kgo[i] = kr_ * LDK + kc_; klo[i] = KSWZ(kr_, kc_ * 2); }
  const int vgo = sr * LDV + sc;
  const int vb0 = (int)(uintptr_t)V_lds + v_rd_base(lane);
  bf16x8 vs0, vs1, ks0, ks1, ks2;
  const int NT = 4 * qb + 4, cwt = 4 * qb + (wid >> 1);
#define SLOAD(k0) do { const bf16_t* vp_ = Vh + (size_t)(k0) * LDV + vgo; const bf16_t* kp_ = Kh + (size_t)(k0) * LDK; \
    vs0 = *reinterpret_cast<const bf16x8*>(vp_); vs1 = *reinterpret_cast<const bf16x8*>(vp_ + 32 * LDV); \
    ks0 = *reinterpret_cast<const bf16x8*>(kp_ + kgo[0]); ks1 = *reinterpret_cast<const bf16x8*>(kp_ + kgo[1]); ks2 = *reinterpret_cast<const bf16x8*>(kp_ + kgo[2]); } while (0)
#define SWRITE(b) do { *(bf16x8*)(V_lds + (b) * SHM_V + vst0) = vs0; *(bf16x8*)(V_lds + (b) * SHM_V + vst1) = vs1; \
    *(bf16x8*)(K_lds + (b) * SHM_K + klo[0]) = ks0; *(bf16x8*)(K_lds + (b) * SHM_K + klo[1]) = ks1; *(bf16x8*)(K_lds + (b) * SHM_K + klo[2]) = ks2; } while (0)
#define SWAIT() asm volatile("s_waitcnt vmcnt(0)" ::: "memory")
#define RESC(a) do { if (__any((a) < 1.f)) { if (hi == 0) al_l[r32] = (a); asm volatile("s_waitcnt lgkmcnt(0)" ::: "memory"); \
    _Pragma("unroll") for (int d = 0; d < 4; ++d) _Pragma("unroll") for (int r = 0; r < 16; ++r) o[d][r] *= al_l[crow(r, hi)]; } } while (0)
#define QKT(P0, P1, KB_, j) do { if ((j) <= cwt) qkt(P0, P1, KB_, qr, r32, hi); else { _Pragma("unroll") for (int r_ = 0; r_ < 16; ++r_) { P0[r_] = -1e30f; P1[r_] = -1e30f; } } } while (0)
#define PV(vb_, j) do { if ((j) <= cwt) pv_d0(o, vb_, pa0, pa1, pa2, pa3); } while (0)
  f32x16 pA0, pA1, pB0, pB1; float mnA, mnB, alA, alB; bf16x8 pa0, pa1, pa2, pa3;
  { bf16x8 ws0, ws1, xs0, xs1, xs2;
    { const bf16_t* vp_ = Vh + (size_t)KVBLK * LDV + vgo; const bf16_t* kp_ = Kh + (size_t)KVBLK * LDK;
      SLOAD(0);
      ws0 = *reinterpret_cast<const bf16x8*>(vp_); ws1 = *reinterpret_cast<const bf16x8*>(vp_ + 32 * LDV);
      xs0 = *reinterpret_cast<const bf16x8*>(kp_ + kgo[0]); xs1 = *reinterpret_cast<const bf16x8*>(kp_ + kgo[1]); xs2 = *reinterpret_cast<const bf16x8*>(kp_ + kgo[2]); }
    SWAIT(); SWRITE(0);
    *(bf16x8*)(V_lds + SHM_V + vst0) = ws0; *(bf16x8*)(V_lds + SHM_V + vst1) = ws1;
    *(bf16x8*)(K_lds + SHM_K + klo[0]) = xs0; *(bf16x8*)(K_lds + SHM_K + klo[1]) = xs1; *(bf16x8*)(K_lds + SHM_K + klo[2]) = xs2; }
  __syncthreads();
  QKT(pA0, pA1, K_lds, 0); partialSM(pA0, pA1, m_reg, mnA, alA);
  for (int j = 1; j + 1 < NT; j += 2) {
    SBAR(); QKT(pB0, pB1, K_lds + SHM_K, j);
    finishSM(pA0, pA1, alA, l_reg, pa0, pa1, pa2, pa3); SBAR();
    SLOAD((j + 1) * KVBLK); SBAR();
    PV(vb0, j - 1); partialSM(pB0, pB1, m_reg, mnB, alB);
    __syncthreads(); SWAIT(); SWRITE(0);
    RESC(alB); __syncthreads();
    SBAR(); QKT(pA0, pA1, K_lds, j + 1);
    finishSM(pB0, pB1, alB, l_reg, pa0, pa1, pa2, pa3); SBAR();
    SLOAD((j + 2) * KVBLK); SBAR();
    PV(vb0 + SHM_V, j); partialSM(pA0, pA1, m_reg, mnA, alA);
    __syncthreads(); SWAIT(); SWRITE(1);
    RESC(alA); __syncthreads();
  }
  SBAR(); QKT(pB0, pB1, K_lds + SHM_K, NT - 1);
  finishSM(pA0, pA1, alA, l_reg, pa0, pa1, pa2, pa3); SBAR();
  PV(vb0, NT - 2); partialSM(pB0, pB1, m_reg, mnB, alB);
  __syncthreads(); RESC(alB);
  finishSM(pB0, pB1, alB, l_reg, pa0, pa1, pa2, pa3); SBAR();
  PV(vb0 + SHM_V, NT - 1);
  if (hi == 0) li_l[r32] = l_reg; asm volatile("s_waitcnt lgkmcnt(0)" ::: "memory");
  __syncthreads();
  char* ot = lds + wid * 8192;
#pragma unroll
  for (int r = 0; r < 16; ++r) { const int orow = crow(r, hi); const float rl = __builtin_amdgcn_rcpf(li_l[orow]);
#pragma unroll
    for (int d0 = 0; d0 < 4; ++d0) *(bf16_t*)(ot + orow * 256 + (d0 * 32 + r32) * 2) = f2bf(o[d0][r] * rl);
    asm volatile("" ::: "memory"); }
  asm volatile("s_waitcnt lgkmcnt(0)" ::: "memory");
  const int ln2 = lane_opaque();
#pragma unroll
  for (int i = 0; i < 8; ++i) { const int orow = i * 4 + (ln2 >> 4), ch = ln2 & 15; const size_t grow = (size_t)(wid * QBLK + orow);
    const u32x4 ov = *(const u32x4*)(ot + orow * 256 + ch * 16); const u32x4 gv = *(const u32x4*)(Gb + grow * 2048 + ch * 8);
    u32x4 w; w.x = cvt_pk_bf16(bf_lo(ov.x) * bf_lo(gv.x), bf_hi(ov.x) * bf_hi(gv.x)); w.y = cvt_pk_bf16(bf_lo(ov.y) * bf_lo(gv.y), bf_hi(ov.y) * bf_hi(gv.y));
    w.z = cvt_pk_bf16(bf_lo(ov.z) * bf_lo(gv.z), bf_hi(ov.z) * bf_hi(gv.z)); w.w = cvt_pk_bf16(bf_lo(ov.w) * bf_lo(gv.w), bf_hi(ov.w) * bf_hi(gv.w));
    *(u32x4*)(Ob + grow * 4096 + ch * 8) = w; if (i & 1) asm volatile("" ::: "memory"); }
  __syncthreads();
#undef SLOAD
#undef SWRITE
#undef SWAIT
#undef RESC
#undef QKT
#undef PV
}
}

namespace ret {
constexpr int QS_STRIDE = 272, T_STRIDE = 144;
constexpr int OFF_QS = 0, OFF_KS = 64 * QS_STRIDE, OFF_KZ = OFF_KS + 64 * QS_STRIDE, OFF_V = OFF_KZ + 16384, OFF_SP = OFF_V + 32768, OFF_ST = OFF_SP + 64 * T_STRIDE, OFF_END = OFF_ST + 8 * 64 * 8;
static_assert(OFF_END <= LDS_BYTES - 16, "retention LDS");
__device__ __forceinline__ int crow(int r, int hi) { return (r & 3) + 8 * (r >> 2) + 4 * hi; }
template <int KS> __device__ __forceinline__ bf16x8 tfrag(int vb) {
  const s16x4 l = att::tr_read<KS * 4096>(vb), h = att::tr_read<KS * 4096 + 2048>(vb);
  asm volatile("s_waitcnt lgkmcnt(0)" ::: "memory"); __builtin_amdgcn_sched_barrier(0);
  return (bf16x8){l[0], l[1], l[2], l[3], h[0], h[1], h[2], h[3]};
}

__device__ __forceinline__ void worker(const bf16_t* __restrict__ RQ, const bf16_t* __restrict__ RK, const bf16_t* __restrict__ RV, const bf16_t* __restrict__ SRG, bf16_t* __restrict__ AR, int b, int h, char* lds) {
  const int tid = tid_opaque(), wid = tid >> 6, lane = tid & 63, r32 = lane & 31, hi = lane >> 5, fr = lane & 15, fq = lane >> 4;
  char* Qs = lds + OFF_QS; char* Ks = lds + OFF_KS; char* Kz = lds + OFF_KZ; char* Vt = lds + OFF_V; char* Sp = lds + OFF_SP; float* St = (float*)(lds + OFF_ST);
  const float lg2 = log2f(1.0f - exp2f(-5.0f - (float)h));
  const int sr = tid >> 4, sc = (tid & 15) * 8;
  const int vst0 = att::v_st(sr, sc), vst1 = att::v_st(32 + sr, sc);
  const float zeta0 = exp2f((float)(63 - sr) * lg2), zeta1 = exp2f((float)(31 - sr) * lg2), dchunk = exp2f(64.0f * lg2);
  float xi[2]; xi[0] = exp2f((float)(r32 + 1) * lg2); xi[1] = exp2f((float)(32 + r32 + 1) * lg2);
  const int kzb = (int)(uintptr_t)Kz + att::v_rd_base(lane);
  const int vtb = (int)(uintptr_t)Vt + (wid >> 2) * 16384 + att::v_rd_base(lane) + (wid & 3) * 512;
  f32x16 R[4];
#pragma unroll
  for (int d = 0; d < 4; ++d) R[d] = f32x16{};
  bf16x8 pq[2], pk[2], pv[4]; u32x2 pg[2][4];
  const size_t tok0 = (size_t)b * SEQ;
#define RLOAD(n) do { const size_t t0_ = tok0 + (size_t)(n) * 64 + sr, t1_ = t0_ + 32; \
    pq[0] = *reinterpret_cast<const bf16x8*>(RQ + t0_ * 1024 + h * 128 + sc); pq[1] = *reinterpret_cast<const bf16x8*>(RQ + t1_ * 1024 + h * 128 + sc); \
    pk[0] = *reinterpret_cast<const bf16x8*>(RK + t0_ * 1024 + h * 128 + sc); pk[1] = *reinterpret_cast<const bf16x8*>(RK + t1_ * 1024 + h * 128 + sc); \
    pv[0] = *reinterpret_cast<const bf16x8*>(RV + t0_ * 2048 + h * 256 + sc); pv[1] = *reinterpret_cast<const bf16x8*>(RV + t1_ * 2048 + h * 256 + sc); \
    pv[2] = *reinterpret_cast<const bf16x8*>(RV + t0_ * 2048 + h * 256 + 128 + sc); pv[3] = *reinterpret_cast<const bf16x8*>(RV + t1_ * 2048 + h * 256 + 128 + sc); } while (0)
#define GLOAD(n) do { _Pragma("unroll") for (int it_ = 0; it_ < 2; ++it_) _Pragma("unroll") for (int g_ = 0; g_ < 4; ++g_) pg[it_][g_] = *(const u32x2*)(SRG + (tok0 + (size_t)(n) * 64 + 32 * it_ + r32) * 2048 + h * 256 + 32 * wid + 8 * g_ + 4 * hi); } while (0)
#define STAGE() do { \
    *(bf16x8*)(Qs + sr * QS_STRIDE + sc * 2) = pq[0]; *(bf16x8*)(Qs + (32 + sr) * QS_STRIDE + sc * 2) = pq[1]; \
    *(bf16x8*)(Ks + sr * QS_STRIDE + sc * 2) = pk[0]; *(bf16x8*)(Ks + (32 + sr) * QS_STRIDE + sc * 2) = pk[1]; \
    { float z[8]; u32x4 w; \
_Pragma("unroll") \
      for (int t = 0; t < 8; ++t) z[t] = bf2f((bf16_t)pk[0][t]) * zeta0; \
      w.x = cvt_pk_bf16(z[0], z[1]); w.y = cvt_pk_bf16(z[2], z[3]); w.z = cvt_pk_bf16(z[4], z[5]); w.w = cvt_pk_bf16(z[6], z[7]); *(u32x4*)(Kz + vst0) = w; \
_Pragma("unroll") \
      for (int t = 0; t < 8; ++t) z[t] = bf2f((bf16_t)pk[1][t]) * zeta1; \
      w.x = cvt_pk_bf16(z[0], z[1]); w.y = cvt_pk_bf16(z[2], z[3]); w.z = cvt_pk_bf16(z[4], z[5]); w.w = cvt_pk_bf16(z[6], z[7]); *(u32x4*)(Kz + vst1) = w; } \
    *(bf16x8*)(Vt + vst0) = pv[0]; *(bf16x8*)(Vt + vst1) = pv[1]; *(bf16x8*)(Vt + 16384 + vst0) = pv[2]; *(bf16x8*)(Vt + 16384 + vst1) = pv[3]; } while (0)
  RLOAD(0); STAGE();
  for (int n = 0; n < 64; ++n) {
    __syncthreads();
    { const int n1 = n + 1 < 64 ? n + 1 : 63; RLOAD(n1); }
    GLOAD(n);
    {
      const int ti = wid >> 1, tj0 = (wid & 1) * 2;
      f32x4 s0 = {0.f, 0.f, 0.f, 0.f}, s1 = {0.f, 0.f, 0.f, 0.f};
#pragma unroll
      for (int kk = 0; kk < 4; ++kk) {
        const bf16x8 bq = *(const bf16x8*)(Qs + (ti * 16 + fr) * QS_STRIDE + (kk * 32 + fq * 8) * 2);
        const bf16x8 a0 = *(const bf16x8*)(Ks + (tj0 * 16 + fr) * QS_STRIDE + (kk * 32 + fq * 8) * 2);
        const bf16x8 a1 = *(const bf16x8*)(Ks + ((tj0 + 1) * 16 + fr) * QS_STRIDE + (kk * 32 + fq * 8) * 2);
        s0 = __builtin_amdgcn_mfma_f32_16x16x32_bf16(a0, bq, s0, 0, 0, 0);
        s1 = __builtin_amdgcn_mfma_f32_16x16x32_bf16(a1, bq, s1, 0, 0, 0);
      }
      const int it = ti * 16 + fr;
#pragma unroll
      for (int t2 = 0; t2 < 2; ++t2) { const int jb = (tj0 + t2) * 16 + 4 * fq; const f32x4 s = t2 ? s1 : s0; float w[4];
#pragma unroll
        for (int r = 0; r < 4; ++r) { const int dd = it - (jb + r); w[r] = s[r] * exp2f((float)(dd < 0 ? -dd : dd) * lg2); }
        u32x2 pk2; pk2.x = cvt_pk_bf16(w[0], w[1]); pk2.y = cvt_pk_bf16(w[2], w[3]); *(u32x2*)(Sp + it * T_STRIDE + jb * 2) = pk2; }
    }
    __syncthreads();
    f32x16 oc[2]; oc[0] = f32x16{}; oc[1] = f32x16{};
#pragma unroll
    for (int dt = 0; dt < 4; ++dt)
#pragma unroll
      for (int sp = 0; sp < 2; ++sp) {
        u32x4 aw; aw.x = cvt_pk_bf16(R[dt][8 * sp + 0], R[dt][8 * sp + 1]); aw.y = cvt_pk_bf16(R[dt][8 * sp + 2], R[dt][8 * sp + 3]);
        aw.z = cvt_pk_bf16(R[dt][8 * sp + 4], R[dt][8 * sp + 5]); aw.w = cvt_pk_bf16(R[dt][8 * sp + 6], R[dt][8 * sp + 7]);
        const bf16x8 A = *reinterpret_cast<bf16x8*>(&aw);
#pragma unroll
        for (int it = 0; it < 2; ++it) { const char* bp = Qs + (32 * it + r32) * QS_STRIDE + (32 * dt + 16 * sp + 4 * hi) * 2;
          const s16x4 lo = *(const s16x4*)bp, h4 = *(const s16x4*)(bp + 16);
          const bf16x8 B = (bf16x8){lo[0], lo[1], lo[2], lo[3], h4[0], h4[1], h4[2], h4[3]};
          oc[it] = __builtin_amdgcn_mfma_f32_32x32x16_bf16(A, B, oc[it], 0, 0, 0); }
      }
#pragma unroll
    for (int it = 0; it < 2; ++it)
#pragma unroll
      for (int r = 0; r < 16; ++r) oc[it][r] *= xi[it];
    bf16x8 vfr[4]; vfr[0] = tfrag<0>(vtb); vfr[1] = tfrag<1>(vtb); vfr[2] = tfrag<2>(vtb); vfr[3] = tfrag<3>(vtb);
#pragma unroll
    for (int it = 0; it < 2; ++it)
#pragma unroll
      for (int ks = 0; ks < 4; ++ks) { const bf16x8 B = *(const bf16x8*)(Sp + (32 * it + r32) * T_STRIDE + (16 * ks + 8 * hi) * 2);
        oc[it] = __builtin_amdgcn_mfma_f32_32x32x16_bf16(vfr[ks], B, oc[it], 0, 0, 0); }
#pragma unroll
    for (int dt = 0; dt < 4; ++dt) {
#pragma unroll
      for (int r = 0; r < 16; ++r) R[dt][r] *= dchunk;
      const int kb = kzb + dt * 512;
      R[dt] = __builtin_amdgcn_mfma_f32_32x32x16_bf16(tfrag<0>(kb), tfrag<0>(vtb), R[dt], 0, 0, 0);
      R[dt] = __builtin_amdgcn_mfma_f32_32x32x16_bf16(tfrag<1>(kb), tfrag<1>(vtb), R[dt], 0, 0, 0);
      R[dt] = __builtin_amdgcn_mfma_f32_32x32x16_bf16(tfrag<2>(kb), tfrag<2>(vtb), R[dt], 0, 0, 0);
      R[dt] = __builtin_amdgcn_mfma_f32_32x32x16_bf16(tfrag<3>(kb), tfrag<3>(vtb), R[dt], 0, 0, 0);
    }
#pragma unroll
    for (int it = 0; it < 2; ++it) { float s1 = 0.f, s2 = 0.f;
#pragma unroll
      for (int r = 0; r < 16; ++r) { s1 += oc[it][r]; s2 += oc[it][r] * oc[it][r]; }
      s1 = xadd32(s1); s2 = xadd32(s2);
      if (hi == 0) *(f32x2*)(St + (wid * 64 + 32 * it + r32) * 2) = (f32x2){s1, s2}; }
    __syncthreads();
#pragma unroll
    for (int it = 0; it < 2; ++it) { float S1 = 0.f, S2 = 0.f;
#pragma unroll
      for (int w = 0; w < 8; ++w) { const f32x2 v = *(const f32x2*)(St + (w * 64 + 32 * it + r32) * 2); S1 += v.x; S2 += v.y; }
      const float mu = S1 * (1.0f / 256.0f), var = S2 * (1.0f / 256.0f) - mu * mu, rstd = rsqrtf(fmaxf(var, 0.f) + EPS);
      const size_t t = tok0 + (size_t)n * 64 + 32 * it + r32;
#pragma unroll
      for (int g = 0; g < 4; ++g) { const int e = h * 256 + 32 * wid + 8 * g + 4 * hi;
        const u32x2 gw = pg[it][g];
        u32x2 ow; ow.x = cvt_pk_bf16((oc[it][4 * g + 0] - mu) * rstd * bf_lo(gw.x), (oc[it][4 * g + 1] - mu) * rstd * bf_hi(gw.x));
        ow.y = cvt_pk_bf16((oc[it][4 * g + 2] - mu) * rstd * bf_lo(gw.y), (oc[it][4 * g + 3] - mu) * rstd * bf_hi(gw.y));
        *(u32x2*)(AR + t * 4096 + e) = ow; }
    }
    STAGE();
  }
  __syncthreads();
#undef STAGE
#undef GLOAD
#undef RLOAD
}
}

__device__ __forceinline__ int src_in(int n) {
    if (n < 2048) { const int base = n & ~1023, r = n & 1023, hd = r >> 7, p = r & 127; return base + hd * 128 + (p >> 1) + 64 * (p & 1); }
    if (n < 7168) return n;
    if (n < 9216) return n + 64;
    if (n < 13312) return n + 64;
    if (n < 13376) { const int p = n - 13312; return 7168 + (p >> 1) + 32 * (p & 1); }
    return -1;
}
__device__ __forceinline__ int src_q(int n) {
    if (n < 2048) return (n >> 7) * 192 + (n & 127);
    const int r = n - 2048, hd = r >> 6, p = r & 63; return hd * 192 + 128 + (p >> 1) + 32 * (p & 1);
}
__device__ __forceinline__ int src_kv(int n) {
    if (n < 2048) return (n >> 7) * 256 + (n & 127);
    const int r = n - 2048; return (r >> 7) * 256 + 128 + (r & 127);
}

constexpr int CV_T_IN = (DINP / 64) * 32, CV_T_Q = (NQ / 64) * 8, CV_T_KV = (NKV / 64) * 8, CV_T_SQ = 32 * 32;
constexpr int CV_PER_LAYER = CV_T_IN + CV_T_Q + CV_T_KV + 3 * CV_T_SQ, CV_TOTAL = DEPTH * CV_PER_LAYER;

struct CvTile { const float* src; int nsrc; int scol; bf16_t* dst; const float* ksc; };
__device__ __forceinline__ void cv_decode(const Params& P, int tile, int nl, CvTile& c, int& dstride) {
    const int l = tile / CV_PER_LAYER; int r = tile % CV_PER_LAYER; unsigned char* ws = P.ws;
    if (r < CV_T_IN) { const int tn = r >> 5, tk = r & 31; c.nsrc = DIN; c.src = P.w_in + (size_t)l * DM * DIN + (size_t)tk * 64 * DIN; c.scol = src_in(tn * 64 + nl);
        dstride = DM; c.dst = (bf16_t*)(ws + WS_WT_IN + l * SZ_WT_IN) + (size_t)tn * 64 * DM + tk * 64; c.ksc = nullptr; return; }
    r -= CV_T_IN;
    if (r < CV_T_Q) { const int tn = r >> 3, tk = r & 7; c.nsrc = NQ; c.src = P.w_uq + (size_t)l * 512 * NQ + (size_t)tk * 64 * NQ; c.scol = src_q(tn * 64 + nl);
        dstride = 512; c.dst = (bf16_t*)(ws + WS_WT_Q + l * SZ_WT_Q) + (size_t)tn * 64 * 512 + tk * 64; c.ksc = P.g_cq + l * 512 + tk * 64; return; }
    r -= CV_T_Q;
    if (r < CV_T_KV) { const int tn = r >> 3, tk = r & 7; c.nsrc = NKV; c.src = P.w_ukv + (size_t)l * 512 * NKV + (size_t)tk * 64 * NKV; c.scol = src_kv(tn * 64 + nl);
        dstride = 512; c.dst = (bf16_t*)(ws + WS_WT_KV + l * SZ_WT_KV) + (size_t)tn * 64 * 512 + tk * 64; c.ksc = P.g_ckv + l * 512 + tk * 64; return; }
    r -= CV_T_KV;
    const int which = r / CV_T_SQ; r %= CV_T_SQ; const int tn = r >> 5, tk = r & 31;
    const size_t soff = (size_t)l * DM * DM + (size_t)tk * 64 * DM;
    c.nsrc = DM; c.scol = tn * 64 + nl; c.ksc = nullptr;
    if (which == 0) { c.src = P.w_ret + soff; dstride = 4096; c.dst = (bf16_t*)(ws + WS_WT_RM + l * SZ_WT_RM) + (size_t)tn * 64 * 4096 + tk * 64; return; }
    if (which == 1) { c.src = P.w_mla + soff; dstride = 4096; c.dst = (bf16_t*)(ws + WS_WT_RM + l * SZ_WT_RM) + (size_t)tn * 64 * 4096 + 2048 + tk * 64; return; }
    c.src = P.w_out + soff; dstride = DM; c.dst = (bf16_t*)(ws + WS_WT_O + l * SZ_WT_O) + (size_t)tn * 64 * DM + tk * 64;
}

__device__ __forceinline__ void phase_p0a(const Params& P, char* lds) {
    const int tid = tid_opaque(), G = gridDim.x, bid = blockIdx.x;
    if (bid == 0 && tid < 64) ((unsigned*)(P.ws + WS_CTR))[tid] = 0u;
    float* cosr = (float*)(P.ws + WS_COSR); float* sinr = (float*)(P.ws + WS_SINR); float* cosm = (float*)(P.ws + WS_COSM); float* sinm = (float*)(P.ws + WS_SINM);
    for (int i = bid * NTHREADS + tid; i < T_TOK * 96; i += G * NTHREADS) {
        const int t = i / 96, j = i % 96; const float pos = (float)P.pos[t];
        const int jj = j < 64 ? j : j - 64; const float inv = j < 64 ? P.inv_r[jj] : P.inv_m[jj]; const float a = pos * inv;
        const float kf = rintf(a * 0.15915494309189535f); float r = fmaf(-kf, 6.28125f, a); r = fmaf(-kf, 0.0019354820251464844f, r); r = fmaf(-kf, -1.7484555314695172e-07f, r);
        const float rf = r * 0.15915494309189535f; const float cv = __builtin_amdgcn_cosf(rf), sv = __builtin_amdgcn_sinf(rf);
        if (j < 64) { cosr[t * 64 + jj] = cv; sinr[t * 64 + jj] = sv; } else { cosm[t * 32 + jj] = cv; sinm[t * 32 + jj] = sv; }
    }
    {
        float* cact = (float*)lds; float* part = (float*)(lds + 32768);
        for (int i = tid; i < 4 * 2048; i += NTHREADS) cact[i] = silu_f(P.c[i]);
        __syncthreads();
        float* mod = (float*)(P.ws + WS_MOD);
        const int cn = tid & 63, ks = tid >> 6;
        for (int item = bid; item < DEPTH * 96; item += G) {
            const int l = item / 96, n0 = (item % 96) * 64;
            const float* wp = P.w_mod + ((size_t)l * DM + ks * 256) * 6144 + n0 + cn;
            float a0 = 0.f, a1 = 0.f, a2 = 0.f, a3 = 0.f;
#pragma unroll 8
            for (int k = 0; k < 256; ++k) { const float w = wp[(size_t)k * 6144]; const int kk = ks * 256 + k; a0 += cact[kk] * w; a1 += cact[2048 + kk] * w; a2 += cact[4096 + kk] * w; a3 += cact[6144 + kk] * w; }
            *(f32x4*)(part + (ks * 64 + cn) * 4) = (f32x4){a0, a1, a2, a3};
            __syncthreads();
            if (tid < 256) { const int c2 = tid & 63, b = tid >> 6; float s = P.b_mod[l * 6144 + n0 + c2];
#pragma unroll
                for (int q = 0; q < 8; ++q) s += part[(q * 64 + c2) * 4 + b];
                mod[((size_t)l * 4 + b) * 6144 + n0 + c2] = s; }
            __syncthreads();
        }
    }
    {
        float* tl = (float*)lds;
        const int nl = tid & 63, kr = tid >> 6;
        float v[8]; CvTile c; int dstride = 0;
        int tile = bid;
        if (tile < CV_TOTAL) { cv_decode(P, tile, nl, c, dstride);
#pragma unroll
            for (int i = 0; i < 8; ++i) v[i] = c.scol >= 0 ? c.src[(size_t)(kr + 8 * i) * c.nsrc + c.scol] : 0.f; }
        while (tile < CV_TOTAL) {
#pragma unroll
            for (int i = 0; i < 8; ++i) tl[(kr + 8 * i) * 65 + nl] = v[i];
            __syncthreads();
            bf16_t* dst = c.dst; const int ds = dstride; const float sc = c.ksc ? c.ksc[nl] : 1.0f;
            const int nxt = tile + G;
            if (nxt < CV_TOTAL) { cv_decode(P, nxt, nl, c, dstride);
#pragma unroll
                for (int i = 0; i < 8; ++i) v[i] = c.scol >= 0 ? c.src[(size_t)(kr + 8 * i) * c.nsrc + c.scol] : 0.f; }
#pragma unroll
            for (int i = 0; i < 8; ++i) { const int nn = kr + 8 * i; dst[(size_t)nn * ds + nl] = f2bf(tl[nl * 65 + nn] * sc); }
            __syncthreads();
            tile = nxt;
        }
    }
}

__device__ __forceinline__ void phase_p0b(const Params& P) {
    const int tid = tid_opaque(), lane = tid & 63, gw = blockIdx.x * 8 + (tid >> 6), GW = gridDim.x * 8;
    const float* mod = (const float*)(P.ws + WS_MOD);
    bf16_t* XG = (bf16_t*)(P.ws + WS_XG); float* ssqx = (float*)(P.ws + WS_SSQX);
    for (int row = gw; row < T_TOK; row += GW) {
        const int b = row >> 12; float ss = 0.f;
#pragma unroll
        for (int i = 0; i < 8; ++i) { const int col = (i * 64 + lane) * 4; const f32x4 x = *(const f32x4*)(P.x + (size_t)row * DM + col);
            const f32x4 g = *(const f32x4*)(P.g_norm + col), s = *(const f32x4*)(mod + (size_t)b * 6144 + 2048 + col); const f32x4 y = x * g * (s + 1.0f);
            ss += (x[0] * x[0] + x[1] * x[1]) + (x[2] * x[2] + x[3] * x[3]);
            u32x2 w; w.x = cvt_pk_bf16(y[0], y[1]); w.y = cvt_pk_bf16(y[2], y[3]); *(u32x2*)(XG + (size_t)row * DM + col) = w; }
#pragma unroll
        for (int o = 32; o >= 1; o >>= 1) ss += __shfl_xor(ss, o);
        if (lane < 32) ssqx[(size_t)row * 32 + lane] = lane == 0 ? ss : 0.f;
    }
    float* bias2 = (float*)(P.ws + WS_BIAS2);
    for (int r = gw; r < DEPTH * DINP; r += GW) {
        const int l = r / DINP, n = r % DINP;
        const bf16_t* wrow = (const bf16_t*)(P.ws + WS_WT_IN + l * SZ_WT_IN) + (size_t)n * DM;
        float a[4] = {0.f, 0.f, 0.f, 0.f};
#pragma unroll
        for (int i = 0; i < 4; ++i) { const int k = (i * 64 + lane) * 8; const u32x4 w = *(const u32x4*)(wrow + k);
            const float wf[8] = {bf_lo(w.x), bf_hi(w.x), bf_lo(w.y), bf_hi(w.y), bf_lo(w.z), bf_hi(w.z), bf_lo(w.w), bf_hi(w.w)};
#pragma unroll
            for (int b = 0; b < 4; ++b) { const float* sp = mod + ((size_t)l * 4 + b) * 6144 + k; const f32x4 s0 = *(const f32x4*)sp, s1 = *(const f32x4*)(sp + 4);
                a[b] += (wf[0] * s0[0] + wf[1] * s0[1]) + (wf[2] * s0[2] + wf[3] * s0[3]) + (wf[4] * s1[0] + wf[5] * s1[1]) + (wf[6] * s1[2] + wf[7] * s1[3]); } }
#pragma unroll
        for (int b = 0; b < 4; ++b) {
#pragma unroll
            for (int o = 32; o >= 1; o >>= 1) a[b] += __shfl_xor(a[b], o); }
        if (lane < 4) bias2[((size_t)l * 4 + lane) * DINP + n] = lane == 0 ? a[0] : lane == 1 ? a[1] : lane == 2 ? a[2] : a[3];
    }
}

__device__ __forceinline__ void phase_final(const Params& P) {
    const int tid = tid_opaque(), lane = tid & 63, gw = blockIdx.x * 8 + (tid >> 6), GW = gridDim.x * 8;
    const float* ssqx = (const float*)(P.ws + WS_SSQX);
    for (int row = gw; row < T_TOK; row += GW) {
        float ss = lane < 32 ? ssqx[(size_t)row * 32 + lane] : 0.f;
#pragma unroll
        for (int o = 32; o >= 1; o >>= 1) ss += __shfl_xor(ss, o);
        const float rinv = rsqrtf(ss * (1.0f / 2048.0f) + EPS);
#pragma unroll
        for (int i = 0; i < 8; ++i) { const int col = (i * 64 + lane) * 4; float* p = P.out + (size_t)row * DM + col; const f32x4 x = *(const f32x4*)p; const f32x4 g = *(const f32x4*)(P.g_final + col);
            *(f32x4*)p = x * rinv * g; }
    }
}

constexpr int N_PHASES = 2 + 5 * DEPTH + 1;

template <int S_>
__device__ __forceinline__ void layer_phase(const Params& P, int l, unsigned char* lds_raw) {
    __attribute__((address_space(1))) unsigned char* wsg = (__attribute__((address_space(1))) unsigned char*)P.ws; asm volatile("" : "+s"(wsg)); unsigned char* ws = (unsigned char*)wsg;
    char* lds = (char*)lds_raw; PG8_LAS unsigned char* lds3 = (PG8_LAS unsigned char*)lds_raw;
    const int G = gridDim.x; int bid = blockIdx.x; asm volatile("" : "+s"(bid));
    float* ssqx = (float*)(ws + WS_SSQX); float* ssqc = (float*)(ws + WS_SSQC);
    const float* cosr = (const float*)(ws + WS_COSR); const float* sinr = (const float*)(ws + WS_SINR); const float* cosm = (const float*)(ws + WS_COSM); const float* sinm = (const float*)(ws + WS_SINM);
    bf16_t* XG = (bf16_t*)(ws + WS_XG); bf16_t* RQ = (bf16_t*)(ws + WS_RQ); bf16_t* RK = (bf16_t*)(ws + WS_RK); bf16_t* RV = (bf16_t*)(ws + WS_RV); bf16_t* SRG = (bf16_t*)(ws + WS_SRG); bf16_t* SMG = (bf16_t*)(ws + WS_SMG);
    bf16_t* CQ = (bf16_t*)(ws + WS_CQ); bf16_t* CKV = (bf16_t*)(ws + WS_CKV); bf16_t* GATE = (bf16_t*)(ws + WS_GATE); bf16_t* QB = (bf16_t*)(ws + WS_QB); bf16_t* KB = (bf16_t*)(ws + WS_KB); bf16_t* VB = (bf16_t*)(ws + WS_VB);
    bf16_t* AR = (bf16_t*)(ws + WS_AR); bf16_t* MERGED = (bf16_t*)(ws + WS_MERGED);
    const float* mod = (const float*)(ws + WS_MOD);
    if constexpr (S_ == 0) {
        pg8::Gemm g{XG, (const bf16_t*)(ws + WS_WT_IN + l * SZ_WT_IN), T_TOK, DINP, DM}; pg8::StaticOrder S; S.init(T_TOK, DINP, G, bid);
        EpiIn E{ssqx, (const float*)(ws + WS_BIAS2) + (size_t)l * 4 * DINP, cosr, sinr, cosm, sinm, RQ, RK, RV, SRG, CQ, CKV, SMG, GATE, KB, ssqc};
        pg8::gemm_phase<EpiIn, pg8::StaticOrder>(lds3, g, S, E);
    } else if constexpr (S_ == 1) {
        { pg8::Gemm g{CQ, (const bf16_t*)(ws + WS_WT_Q + l * SZ_WT_Q), T_TOK, NQ, 512}; pg8::StaticOrder S; S.init(T_TOK, NQ, G, bid);
          EpiUp<0> E{ssqc, cosm, sinm, QB, KB, VB}; pg8::gemm_phase<EpiUp<0>, pg8::StaticOrder>(lds3, g, S, E); }
        { pg8::Gemm g{CKV, (const bf16_t*)(ws + WS_WT_KV + l * SZ_WT_KV), T_TOK, NKV, 512}; pg8::StaticOrder S; S.init(T_TOK, NKV, G, bid);
          EpiUp<1> E{ssqc, cosm, sinm, QB, KB, VB}; pg8::gemm_phase<EpiUp<1>, pg8::StaticOrder>(lds3, g, S, E); }
    } else if constexpr (S_ == 2) {
#if defined(SKIP_RET)
        for (size_t i = (size_t)bid * NTHREADS + threadIdx.x; i < (size_t)T_TOK * 256; i += (size_t)G * NTHREADS) { const size_t t = i >> 8, c = (i & 255) * 8; *(u32x4*)(AR + t * 4096 + c) = *(const u32x4*)(SRG + t * 2048 + c); }
#else
        if (bid < 32 && P.ph_hi != 77) ret::worker(RQ, RK, RV, SRG, AR, bid >> 3, bid & 7, lds);
#endif
#if defined(SKIP_ATT)
        for (size_t i = (size_t)bid * NTHREADS + threadIdx.x; i < (size_t)T_TOK * 256; i += (size_t)G * NTHREADS) { const size_t t = i >> 8, c = (i & 255) * 8; *(u32x4*)(AR + t * 4096 + 2048 + c) = *(const u32x4*)(SMG + t * 2048 + c); }
        if (false)
#endif
        {
            unsigned* ctr = (unsigned*)(ws + WS_CTR) + l; PG8_LAS unsigned* slot = (PG8_LAS unsigned*)(lds_raw + LDS_BYTES - 16);
            for (;;) {
                if (threadIdx.x == 0) *slot = __hip_atomic_fetch_add(ctr, 1u, __ATOMIC_RELAXED, __HIP_MEMORY_SCOPE_AGENT);
                __syncthreads();
                const int it = (int)*slot;
                __syncthreads();
                if (it >= 1024) break;
                const int qb = 15 - (it >> 6), bh = it & 63, b = bh >> 4, h = bh & 15;
                const size_t row0 = (size_t)b * SEQ + qb * 256;
                att::attn_item(QB + row0 * 3072 + h * 192, KB + (size_t)b * SEQ * 3072 + h * 192, VB + (size_t)b * SEQ * 2048 + h * 128, AR + row0 * 4096 + 2048 + h * 128, SMG + row0 * 2048 + h * 128, qb, lds);
            }
        }
    } else if constexpr (S_ == 3) {
        pg8::Gemm g{AR, (const bf16_t*)(ws + WS_WT_RM + l * SZ_WT_RM), T_TOK, DM, 4096}; pg8::StaticOrder S; S.init(T_TOK, DM, G, bid);
        EpiMerge E{GATE, MERGED}; pg8::gemm_phase<EpiMerge, pg8::StaticOrder>(lds3, g, S, E);
    } else {
        pg8::Gemm g{MERGED, (const bf16_t*)(ws + WS_WT_O + l * SZ_WT_O), T_TOK, DM, DM}; pg8::StaticOrder S; S.init(T_TOK, DM, G, bid);
        const bool lastl = (l == DEPTH - 1);
        const int ln = lastl ? 0 : l + 1;
        EpiOut E{l == 0 ? P.x : P.out, P.out, mod + (size_t)l * 4 * 6144 + 4096, P.g_norm + ln * DM, mod + (size_t)ln * 4 * 6144 + 2048, XG, ssqx};
        pg8::gemm_phase<EpiOut, pg8::StaticOrder>(lds3, g, S, E);
    }
}

__device__ __forceinline__ void run_phase(const Params& P, int ph, unsigned char* lds_raw) {
    if (ph == 0) { phase_p0a(P, (char*)lds_raw); return; }
    if (ph == 1) { phase_p0b(P); return; }
    if (ph == N_PHASES - 1) { phase_final(P); return; }
    const int l = (ph - 2) / 5, s = (ph - 2) % 5;
    if (s == 0) layer_phase<0>(P, l, lds_raw);
    else if (s == 1) layer_phase<1>(P, l, lds_raw);
    else if (s == 2) layer_phase<2>(P, l, lds_raw);
    else if (s == 3) layer_phase<3>(P, l, lds_raw);
    else layer_phase<4>(P, l, lds_raw);
}


#define XB_TMO      128
#define XB_XCNT(j)  (256  + 64 * (j))
#define XB_XSUB(j)  (1280 + 64 * (j))
#define XB_XGEN(j)  (2304 + 64 * (j))
#define XB_TOP      3328
#define XB_TOPGEN   3392
#define XCD_BAR_WORDS 3456
#define XB_SPIN_CAP (1u << 18)
__device__ __forceinline__ unsigned xb_ld(unsigned* p)              { return __hip_atomic_load(p, __ATOMIC_RELAXED, __HIP_MEMORY_SCOPE_AGENT); }
__device__ __forceinline__ unsigned xb_add(unsigned* p, unsigned v) { return __hip_atomic_fetch_add(p, v, __ATOMIC_RELAXED, __HIP_MEMORY_SCOPE_AGENT); }
__device__ __forceinline__ unsigned xb_xcc_id() { return (unsigned)__builtin_amdgcn_s_getreg((3 << 11) | 20) & 0xFu; }
#define XB_SPIN(cond, bar) do { unsigned _sp = 0; while (cond) { __builtin_amdgcn_s_sleep(1); \
    if ((++_sp & 255u) == 0u) { if (xb_ld(&(bar)[XB_TMO])) break; if (_sp > XB_SPIN_CAP) { atomicAdd(&(bar)[XB_TMO], 1u); break; } } } } while (0)
struct XcdBarrier { unsigned* bar; unsigned x; volatile PG8_LAS unsigned* st; };
__device__ __forceinline__ void xcd_barrier_complete(unsigned* bar, unsigned x, unsigned& nloc, unsigned& nx) {
    const unsigned G = gridDim.x * gridDim.y * gridDim.z;
    unsigned sum, cnt, mine, sp = 0u;
    for (;;) {
        sum = 0u; cnt = 0u; mine = 0u;
#pragma unroll
        for (unsigned j = 0; j < 16; ++j) { const unsigned c = xb_ld(&bar[XB_XCNT(j)]); sum += c; cnt += (c > 0u) ? 1u : 0u; mine = (j == x) ? c : mine; }
        if (sum == G) break;
        __builtin_amdgcn_s_sleep(1);
        if ((++sp & 255u) == 0u) { if (xb_ld(&bar[XB_TMO])) break; if (sp > XB_SPIN_CAP) { atomicAdd(&bar[XB_TMO], 1u); break; } }
    }
    nloc = mine > 0u ? mine : 1u; nx = cnt > 0u ? cnt : 1u;
}
__device__ __forceinline__ void xcd_barrier(const XcdBarrier& b) {
    asm volatile("s_waitcnt vmcnt(0)" ::: "memory");
    __syncthreads();
    if (threadIdx.x == 0) {
        unsigned* bar = b.bar;
        __builtin_amdgcn_s_waitcnt(0);
        unsigned nloc = b.st[0], nx = b.st[1];
        if (nloc == 0u) { xcd_barrier_complete(bar, b.x, nloc, nx); b.st[0] = nloc; b.st[1] = nx; }
        const unsigned old = xb_add(&bar[XB_XSUB(b.x)], 1u);
        const unsigned gen = old / nloc;
        if (old + 1u == (gen + 1u) * nloc) {
            __builtin_amdgcn_fence(__ATOMIC_RELEASE, "agent");
            asm volatile("s_waitcnt vmcnt(0)" ::: "memory");
            const unsigned og = xb_add(&bar[XB_TOP], 1u);
            const unsigned tg = og / nx;
            if (og + 1u == (tg + 1u) * nx) xb_add(&bar[XB_TOPGEN], 1u);
            else XB_SPIN(xb_ld(&bar[XB_TOPGEN]) == tg, bar);
            __builtin_amdgcn_fence(__ATOMIC_ACQUIRE, "agent");
            xb_add(&bar[XB_XGEN(b.x)], 1u);
            asm volatile("s_waitcnt vmcnt(0)" ::: "memory");
        } else {
            XB_SPIN(xb_ld(&bar[XB_XGEN(b.x)]) == gen, bar);
            __builtin_amdgcn_fence(__ATOMIC_ACQUIRE, "agent");
            asm volatile("s_waitcnt vmcnt(0)" ::: "memory");
        }
    }
    __syncthreads();
}

#if MK_COOP
__global__ void __launch_bounds__(NTHREADS) hybrid_fwd(Params P) {
    extern __shared__ __attribute__((aligned(16))) unsigned char lds_raw[];
#if defined(MK_PROBE)
    if (blockIdx.x == 0 && threadIdx.x == 0) { unsigned long long* tm = (unsigned long long*)(P.ws + WS_END); for (int i = 0; i < 16; ++i) tm[i] = 0; tm[16] = wall_clock64(); }
#endif
    { volatile PG8_LAS unsigned* st = (volatile PG8_LAS unsigned*)(PG8_LAS unsigned char*)(lds_raw + LDS_GEMM);
      if (threadIdx.x < 2) st[threadIdx.x] = 0u;
      __syncthreads();
      if (threadIdx.x == 0) (void)xb_add(&((unsigned*)(P.ws + WS_XBAR))[XB_XCNT(xb_xcc_id())], 1u); }
    for (int ph = P.ph_lo; ph < P.ph_hi; ++ph) {
        if (ph == P.ph_lo + 1) cg::this_grid().sync();
        else if (ph > P.ph_lo) { XcdBarrier xb_; xb_.bar = (unsigned*)(P.ws + WS_XBAR); xb_.x = xb_xcc_id(); xb_.st = (volatile PG8_LAS unsigned*)(PG8_LAS unsigned char*)(lds_raw + LDS_GEMM); xcd_barrier(xb_); }
        run_phase(P, ph, lds_raw);
#if defined(MK_REPEAT)
        { const int kind = ph == 0 ? 0 : (ph == 1 ? 1 : (ph == N_PHASES - 1 ? 7 : 2 + (ph - 2) % 5)); if (kind == MK_REPEAT) { cg::this_grid().sync(); if (kind == 4 && blockIdx.x == 0 && threadIdx.x == 0) ((unsigned*)(P.ws + WS_CTR))[(ph - 2) / 5] = 0u; cg::this_grid().sync(); run_phase(P, ph, lds_raw); } }
#endif
#if defined(MK_PROBE)
        cg::this_grid().sync();
        if (blockIdx.x == 0 && threadIdx.x == 0) { unsigned long long* tm = (unsigned long long*)(P.ws + WS_END); const unsigned long long t = wall_clock64();
            const int kind = ph == 0 ? 0 : (ph == 1 ? 1 : (ph == N_PHASES - 1 ? 7 : 2 + (ph - 2) % 5)); tm[kind] += t - tm[16]; tm[16] = t; }
#endif
    }
#if defined(MK_PROBE)
    cg::this_grid().sync();
    if (blockIdx.x == 0) { const unsigned long long* tm = (const unsigned long long*)(P.ws + WS_END); const float ua = (float)tm[MK_PROBE_A] * 0.01f, ub = (float)tm[MK_PROBE_B] * 0.01f; int n = (int)(ub / 50.f) + 1; if (n > 99) n = 99;
        for (int i = threadIdx.x; i < n; i += NTHREADS) P.out[i] = 10.f * ua; }
#endif
}
#else
__global__ void __launch_bounds__(NTHREADS) k_p0a(Params P) { extern __shared__ __attribute__((aligned(16))) unsigned char lds_raw[]; phase_p0a(P, (char*)lds_raw); }
__global__ void __launch_bounds__(NTHREADS) k_p0b(Params P) { phase_p0b(P); }
__global__ void __launch_bounds__(NTHREADS) k_final(Params P) { phase_final(P); }
template <int S_> __global__ void __launch_bounds__(NTHREADS) k_layer(Params P) { extern __shared__ __attribute__((aligned(16))) unsigned char lds_raw[]; layer_phase<S_>(P, P.ph_lo, lds_raw); }
#endif

#if defined(MK_PROBE) && !MK_COOP
__global__ void k_stamp(Params P, int kind) { unsigned long long* tm = (unsigned long long*)(P.ws + WS_END); const unsigned long long t = wall_clock64();
    if (kind < 0) { for (int i = 0; i < 16; ++i) tm[i] = 0; } else tm[kind] += t - tm[16]; tm[16] = t; }
__global__ void k_probe_report(Params P) { const unsigned long long* tm = (const unsigned long long*)(P.ws + WS_END); const float ua = (float)tm[MK_PROBE_A] * 0.01f, ub = (float)tm[MK_PROBE_B] * 0.01f; int n = (int)(ub / 50.f) + 1; if (n > 99) n = 99;
    for (int i = threadIdx.x; i < n; i += blockDim.x) P.out[i] = 10.f * ua; }
#define STAMP(k) hipLaunchKernelGGL(k_stamp, dim3(1), dim3(1), 0, stream, p, (k))
#else
#define STAMP(k) do { } while (0)
#endif

extern "C" void kernel_launch(void* const* d_in, const int* in_sizes, int n_in, void* d_out, int out_size, void* d_ws, size_t ws_size, hipStream_t stream) {
    static int grid = 0;
    if (grid == 0) {
        if (n_in != 15 || out_size != T_TOK * DM || ws_size < WS_TOTAL) { fprintf(stderr, "kernel_launch: unexpected shapes (n_in %d, out %d, ws %zu < %zu)\n", n_in, out_size, ws_size, (size_t)WS_TOTAL); grid = -1; return; }
        int dev = 0, cus = 0; bool ok = true;
        ok = ok && hipGetDevice(&dev) == hipSuccess; ok = ok && hipDeviceGetAttribute(&cus, hipDeviceAttributeMultiprocessorCount, dev) == hipSuccess;
#if MK_COOP
        int per_cu = 0;
        ok = ok && hipFuncSetAttribute((const void*)hybrid_fwd, hipFuncAttributeMaxDynamicSharedMemorySize, LDS_BYTES) == hipSuccess;
        if (hipOccupancyMaxActiveBlocksPerMultiprocessor(&per_cu, (const void*)hybrid_fwd, NTHREADS, LDS_BYTES) != hipSuccess || per_cu < 1) { fprintf(stderr, "kernel_launch: occupancy query says %d blocks per CU\n", per_cu); }
        (void)hipGetLastError();
#else
        ok = ok && hipFuncSetAttribute((const void*)k_p0a, hipFuncAttributeMaxDynamicSharedMemorySize, LDS_BYTES) == hipSuccess;
        ok = ok && hipFuncSetAttribute((const void*)k_layer<0>, hipFuncAttributeMaxDynamicSharedMemorySize, LDS_BYTES) == hipSuccess;
        ok = ok && hipFuncSetAttribute((const void*)k_layer<1>, hipFuncAttributeMaxDynamicSharedMemorySize, LDS_BYTES) == hipSuccess;
        ok = ok && hipFuncSetAttribute((const void*)k_layer<2>, hipFuncAttributeMaxDynamicSharedMemorySize, LDS_BYTES) == hipSuccess;
        ok = ok && hipFuncSetAttribute((const void*)k_layer<3>, hipFuncAttributeMaxDynamicSharedMemorySize, LDS_BYTES) == hipSuccess;
        ok = ok && hipFuncSetAttribute((const void*)k_layer<4>, hipFuncAttributeMaxDynamicSharedMemorySize, LDS_BYTES) == hipSuccess;
#endif
        if (!ok || cus < 1) { fprintf(stderr, "kernel_launch: device set-up failed\n"); grid = -1; return; }
        grid = cus;
    }
    if (grid < 0) return;
    Params p{};
    p.x = (const float*)d_in[0]; p.c = (const float*)d_in[1]; p.pos = (const int*)d_in[2]; p.w_mod = (const float*)d_in[3]; p.b_mod = (const float*)d_in[4]; p.g_norm = (const float*)d_in[5];
    p.w_in = (const float*)d_in[6]; p.g_cq = (const float*)d_in[7]; p.g_ckv = (const float*)d_in[8]; p.w_uq = (const float*)d_in[9]; p.w_ukv = (const float*)d_in[10];
    p.w_ret = (const float*)d_in[11]; p.w_mla = (const float*)d_in[12]; p.w_out = (const float*)d_in[13]; p.g_final = (const float*)d_in[14];
    p.out = (float*)d_out; p.ws = (unsigned char*)d_ws;
    for (int j = 0; j < 64; ++j) p.inv_r[j] = (float)(1.0 / pow(10000.0, (double)(2 * j) / 128.0));
    for (int j = 0; j < 32; ++j) p.inv_m[j] = (float)(1.0 / pow(10000.0, (double)(2 * j) / 64.0));
#if MK_COOP
    p.ph_lo = 0; p.ph_hi = N_PHASES;
    if (hipMemsetAsync((char*)d_ws + WS_XBAR, 0, XCD_BAR_WORDS * 4, stream) != hipSuccess) { fprintf(stderr, "kernel_launch: memset of the barrier words failed\n"); return; }
    void* args[] = {&p};
    hipError_t e = hipLaunchCooperativeKernel((const void*)hybrid_fwd, dim3(grid), dim3(NTHREADS), args, LDS_BYTES, stream);
    if (e != hipSuccess) fprintf(stderr, "kernel_launch: cooperative launch failed: %s (grid %d)\n", hipGetErrorString(e), grid);
#else
    p.ph_lo = 0; p.ph_hi = 0;
    STAMP(-1);
    hipLaunchKernelGGL(k_p0a, dim3(grid), dim3(NTHREADS), LDS_BYTES, stream, p); STAMP(0);
#if defined(MK_REPEAT)
    if (MK_REPEAT == 0) hipLaunchKernelGGL(k_p0a, dim3(grid), dim3(NTHREADS), LDS_BYTES, stream, p);
#endif
    hipLaunchKernelGGL(k_p0b, dim3(grid), dim3(NTHREADS), 0, stream, p); STAMP(1);
    for (int l = 0; l < DEPTH; ++l) { p.ph_lo = l;
        hipLaunchKernelGGL(k_layer<0>, dim3(grid), dim3(NTHREADS), LDS_BYTES, stream, p); STAMP(2);
        hipLaunchKernelGGL(k_layer<1>, dim3(grid), dim3(NTHREADS), LDS_BYTES, stream, p); STAMP(3);
        hipLaunchKernelGGL(k_layer<2>, dim3(grid), dim3(NTHREADS), LDS_BYTES, stream, p); STAMP(4);
#if defined(MK_REPEAT)
        if (MK_REPEAT == 4) { (void)hipMemsetAsync((char*)d_ws + WS_CTR, 0, 256, stream); hipLaunchKernelGGL(k_layer<2>, dim3(grid), dim3(NTHREADS), LDS_BYTES, stream, p); }
        if (MK_REPEAT == 44) { (void)hipMemsetAsync((char*)d_ws + WS_CTR, 0, 256, stream); p.ph_hi = 77; hipLaunchKernelGGL(k_layer<2>, dim3(grid), dim3(NTHREADS), LDS_BYTES, stream, p); p.ph_hi = 0; }
        if (MK_REPEAT == 2) hipLaunchKernelGGL(k_layer<0>, dim3(grid), dim3(NTHREADS), LDS_BYTES, stream, p);
        if (MK_REPEAT == 3) hipLaunchKernelGGL(k_layer<1>, dim3(grid), dim3(NTHREADS), LDS_BYTES, stream, p);
#endif
        hipLaunchKernelGGL(k_layer<3>, dim3(grid), dim3(NTHREADS), LDS_BYTES, stream, p); STAMP(5);
#if defined(MK_REPEAT)
        if (MK_REPEAT == 5) hipLaunchKernelGGL(k_layer<3>, dim3(grid), dim3(NTHREADS), LDS_BYTES, stream, p);
#endif
        hipLaunchKernelGGL(k_layer<4>, dim3(grid), dim3(NTHREADS), LDS_BYTES, stream, p); STAMP(6); }
    hipLaunchKernelGGL(k_final, dim3(grid), dim3(NTHREADS), 0, stream, p); STAMP(7);
#if defined(MK_PROBE)
    hipLaunchKernelGGL(k_probe_report, dim3(1), dim3(128), 0, stream, p);
#endif
#endif
}
```

```cpp
#include <hip/hip_runtime.h>
#include <hip/hip_cooperative_groups.h>
#include <cstdio>
#include <cmath>
#include <cstdint>
namespace cg = cooperative_groups;

#ifndef MK_COOP
#define MK_COOP 1
#endif

constexpr int T_TOK = 16384, DM = 2048, NBATCH = 4, SEQ = 4096, DEPTH = 4;
constexpr int DIN = 13376, DINP = 13568;
constexpr int NQ = 3072, NKV = 4096;
constexpr float EPS = 1e-6f;
constexpr int NTHREADS = 512;
constexpr int LDS_GEMM = 131072, LDS_BYTES = LDS_GEMM + 64;

typedef unsigned short bf16_t;
typedef short bf16x8 __attribute__((ext_vector_type(8)));
typedef short s16x4 __attribute__((ext_vector_type(4)));
typedef float f32x4 __attribute__((ext_vector_type(4)));
typedef float f32x2 __attribute__((ext_vector_type(2)));
typedef float f32x16 __attribute__((ext_vector_type(16)));
typedef unsigned u32x4 __attribute__((ext_vector_type(4)));
typedef unsigned u32x2 __attribute__((ext_vector_type(2)));

typedef __bf16 bf16x2_t __attribute__((ext_vector_type(2)));
__device__ __forceinline__ unsigned cvt_pk_bf16(float lo, float hi) { f32x2 v = {lo, hi}; bf16x2_t r = __builtin_convertvector(v, bf16x2_t); return __builtin_bit_cast(unsigned, r); }
__device__ __forceinline__ int tid_opaque() { int t = threadIdx.x; asm volatile("" : "+v"(t)); return t; }
__device__ __forceinline__ int lane_opaque() { int l; asm volatile("v_mbcnt_lo_u32_b32 %0, -1, 0\n\tv_mbcnt_hi_u32_b32 %0, -1, %0" : "=v"(l)); return l; }
__device__ __forceinline__ float xadd32(float x) { auto r = __builtin_amdgcn_permlane32_swap(__float_as_uint(x), __float_as_uint(x), false, false); return __uint_as_float(r[0]) + __uint_as_float(r[1]); }
__device__ __forceinline__ float xadd16(float x) { auto r = __builtin_amdgcn_permlane16_swap(__float_as_uint(x), __float_as_uint(x), false, false); return __uint_as_float(r[0]) + __uint_as_float(r[1]); }
__device__ __forceinline__ float bf_lo(unsigned w) { return __uint_as_float(w << 16); }
__device__ __forceinline__ float bf_hi(unsigned w) { return __uint_as_float(w & 0xffff0000u); }
__device__ __forceinline__ float bf2f(bf16_t v) { return __uint_as_float(((unsigned)v) << 16); }
__device__ __forceinline__ bf16_t f2bf(float f) { return (bf16_t)(cvt_pk_bf16(f, 0.f) & 0xffffu); }
__device__ __forceinline__ float silu_f(float x) { return x * __builtin_amdgcn_rcpf(1.0f + __expf(-x)); }
__device__ __forceinline__ float sigmoid_f(float x) { return __builtin_amdgcn_rcpf(1.0f + __expf(-x)); }

constexpr size_t al256(size_t x) { return (x + 255) / 256 * 256; }
constexpr size_t SZ_WT_IN = (size_t)DINP * DM * 2, SZ_WT_Q = (size_t)NQ * 512 * 2, SZ_WT_KV = (size_t)NKV * 512 * 2, SZ_WT_RM = (size_t)DM * 4096 * 2, SZ_WT_O = (size_t)DM * DM * 2;
constexpr size_t WS_WT_IN = 0;
constexpr size_t WS_WT_Q = WS_WT_IN + DEPTH * SZ_WT_IN;
constexpr size_t WS_WT_KV = WS_WT_Q + DEPTH * SZ_WT_Q;
constexpr size_t WS_WT_RM = WS_WT_KV + DEPTH * SZ_WT_KV;
constexpr size_t WS_WT_O = WS_WT_RM + DEPTH * SZ_WT_RM;
constexpr size_t WS_MOD = WS_WT_O + DEPTH * SZ_WT_O;
constexpr size_t WS_BIAS2 = WS_MOD + al256((size_t)DEPTH * 4 * 6144 * 4);
constexpr size_t WS_COSR = WS_BIAS2 + al256((size_t)DEPTH * 4 * DINP * 4);
constexpr size_t WS_SINR = WS_COSR + (size_t)T_TOK * 64 * 4;
constexpr size_t WS_COSM = WS_SINR + (size_t)T_TOK * 64 * 4;
constexpr size_t WS_SINM = WS_COSM + (size_t)T_TOK * 32 * 4;
constexpr size_t WS_SSQX = WS_SINM + (size_t)T_TOK * 32 * 4;
constexpr size_t WS_SSQC = WS_SSQX + (size_t)T_TOK * 32 * 4;
constexpr size_t WS_CTR = WS_SSQC + (size_t)T_TOK * 16 * 4;
constexpr size_t WS_XG = WS_CTR + 256;
constexpr size_t WS_RQ = WS_XG + (size_t)T_TOK * 2048 * 2;
constexpr size_t WS_RK = WS_RQ + (size_t)T_TOK * 1024 * 2;
constexpr size_t WS_RV = WS_RK + (size_t)T_TOK * 1024 * 2;
constexpr size_t WS_SRG = WS_RV + (size_t)T_TOK * 2048 * 2;
constexpr size_t WS_SMG = WS_SRG + (size_t)T_TOK * 2048 * 2;
constexpr size_t WS_CQ = WS_SMG + (size_t)T_TOK * 2048 * 2;
constexpr size_t WS_CKV = WS_CQ + (size_t)T_TOK * 512 * 2;
constexpr size_t WS_GATE = WS_CKV + (size_t)T_TOK * 512 * 2;
constexpr size_t WS_QB = WS_GATE + (size_t)T_TOK * 4096 * 2;
constexpr size_t WS_KB = WS_QB + (size_t)T_TOK * 3072 * 2;
constexpr size_t WS_VB = WS_KB + (size_t)T_TOK * 3072 * 2;
constexpr size_t WS_AR = WS_VB + (size_t)T_TOK * 2048 * 2;
#if defined(MK_DEBUG)
constexpr size_t WS_MERGED = WS_AR + (size_t)T_TOK * 4096 * 2;
constexpr size_t WS_END = WS_MERGED + (size_t)T_TOK * 2048 * 2;
#else
constexpr size_t WS_MERGED = WS_RQ;
constexpr size_t WS_END = WS_AR + (size_t)T_TOK * 4096 * 2;
#endif
constexpr size_t WS_XBAR = WS_END + 65536;
constexpr size_t WS_TOTAL = WS_XBAR + 16384;

struct Params {
    const float* x; const float* c; const int* pos; const float* w_mod; const float* b_mod; const float* g_norm; const float* w_in; const float* g_cq; const float* g_ckv;
    const float* w_uq; const float* w_ukv; const float* w_ret; const float* w_mla; const float* w_out; const float* g_final;
    float* out; unsigned char* ws; int ph_lo, ph_hi;
    float inv_r[64]; float inv_m[32];
};

namespace pg8 {
#define PG8_LAS __attribute__((address_space(3)))
constexpr int BM = 256, BK = 64, HALF = 128, HTB = HALF * BK * 2  , STAGE_BYTES = 8 * HTB, NXCD = 8, WGM = 8;
__host__ __device__ __forceinline__ int lds_byte(int r, int c) { const int st = (r >> 4) * 2 + (c >> 5), rr = r & 15, cc = c & 31, ob = rr * 64 + cc * 2; return st * 1024 + (ob ^ (((ob >> 9) & 1) << 5)); }
__host__ __device__ __forceinline__ void stage_rc(int b, int& R, int& C) { const int st = b / 1024, sb = b % 1024, swz = sb ^ (((sb >> 9) & 1) << 5); R = (st >> 1) * 16 + swz / 64; C = (st & 1) * 32 + (swz % 64) / 2; }
__host__ __device__ __forceinline__ int perm32(int rho) { const int n = rho >> 4, i = rho & 15; return 8 * (i >> 2) + 4 * n + (i & 3); }

struct Unit { int pm, pn; };
struct Gemm { const bf16_t* A; const bf16_t* Bt; int M, N, K; };

struct StaticOrder {
    int nM, nN, nwg, G, c;
    __host__ __device__ void init(int M, int N, int G_, int c_) { nM = M / BM; nN = N / BM; nwg = nM * nN; G = G_; c = c_; }
    __host__ __device__ bool next(int i, Unit& u) const {
        const long L = (long)i * G + c; if (L >= nwg) return false;
        int wgid = (int)L; { const int q = nwg / NXCD, r = nwg % NXCD, xcd = wgid % NXCD, off = wgid / NXCD; wgid = (xcd < r ? xcd * (q + 1) : r * (q + 1) + (xcd - r) * q) + off; }
        const int nig = WGM * nN, gid = wgid / nig, fm = gid * WGM, gsz = (nM - fm) < WGM ? (nM - fm) : WGM;
        u.pm = fm + ((wgid % nig) % gsz); u.pn = (wgid % nig) / gsz; return true;
    }
    __device__ __forceinline__ void a_ready(const Unit&) const {}
    __device__ __forceinline__ void done(const Unit&) const {}
};

template <class Epi, class Sched>
__device__ __forceinline__ void gemm_phase(PG8_LAS unsigned char* lds, const Gemm g, const Sched& S, const Epi& E) {
    const int tid = tid_opaque(), wid = __builtin_amdgcn_readfirstlane(tid >> 6), lane = tid & 63, wr = wid >> 2, wc = wid & 3, fr = lane & 15, fq = lane >> 4;
    const int K = g.K, nt = K / BK;
    unsigned voffA[2], voffB[2];
#pragma unroll
    for (int i = 0; i < 2; ++i) { int R, C; stage_rc(tid * 16 + i * 8192, R, C); const int Rb = Epi::PERM ? ((R & ~31) + perm32(R & 31)) : R;
        voffA[i] = (unsigned)(R * K + C) * 2u; voffB[i] = (unsigned)(Rb * K + C) * 2u; }
    const size_t kstep = (size_t)(BK * 2);
    const size_t hstep = (size_t)HALF * K * 2;
    const size_t tstep = 2 * hstep;
    const unsigned ldsw = (unsigned)wid * 1024u;
    const int aoff = lds_byte(wr * 64 + fr, fq * 8), boff = lds_byte(wc * 32 + fr, fq * 8);
#define PG8_SA(b, h) (((b) * 2 + (h)) * HTB)
#define PG8_SB(b, h) ((4 + (b) * 2 + (h)) * HTB)
#define PG8_STAGE(bufoff, gbase, voff) do { _Pragma("unroll") for (int _i = 0; _i < 2; ++_i) \
        __builtin_amdgcn_global_load_lds((const unsigned*)((const char*)(gbase) + (voff)[_i]), (PG8_LAS unsigned*)(lds + (bufoff) + ldsw + _i * 8192), 16, 0, 0); } while (0)
#define PG8_LDA(dst, b, h) do { _Pragma("unroll") for (int m = 0; m < 4; ++m) _Pragma("unroll") for (int k = 0; k < 2; ++k) dst[m][k] = *(const PG8_LAS bf16x8*)(lds + PG8_SA(b, h) + aoff + m * 2048 + k * 1024); } while (0)
#define PG8_LDB(dst, b, h) do { _Pragma("unroll") for (int n = 0; n < 2; ++n) _Pragma("unroll") for (int k = 0; k < 2; ++k) dst[n][k] = *(const PG8_LAS bf16x8*)(lds + PG8_SB(b, h) + boff + n * 2048 + k * 1024); } while (0)
#define PG8_MMA(ai, bj, At, Bt) do { __builtin_amdgcn_s_setprio(1); _Pragma("unroll") for (int m = 0; m < 4; ++m) _Pragma("unroll") for (int n = 0; n < 2; ++n) _Pragma("unroll") for (int k = 0; k < 2; ++k) \
        acc[ai][bj][m][n] = __builtin_amdgcn_mfma_f32_16x16x32_bf16(Bt[n][k], At[m][k], acc[ai][bj][m][n], 0, 0, 0); __builtin_amdgcn_s_setprio(0); } while (0)
#define PG8_WAIT_V(n) asm volatile("s_waitcnt vmcnt(" #n ")" ::: "memory")
#define PG8_WAIT_L(n) asm volatile("s_waitcnt lgkmcnt(" #n ")" ::: "memory")
#define PG8_BAR __builtin_amdgcn_s_barrier()
#define PG8_SCHED __builtin_amdgcn_sched_barrier(0)
    Unit cur, nxt; int ui = 0;
    if (!S.next(0, cur)) return;
    f32x4 acc[2][2][4][2];
#pragma unroll
    for (int a = 0; a < 2; ++a)
#pragma unroll
        for (int b = 0; b < 2; ++b)
#pragma unroll
            for (int m = 0; m < 4; ++m)
#pragma unroll
                for (int n = 0; n < 2; ++n) acc[a][b][m][n] = (f32x4){0.f, 0.f, 0.f, 0.f};
    bf16x8 At[4][2], B0[2][2], B1[2][2];
    const char* cA = (const char*)g.A + (size_t)cur.pm * tstep; const char* cB = (const char*)g.Bt + (size_t)cur.pn * tstep;
    S.a_ready(cur);
    PG8_STAGE(PG8_SB(0, 0), cB, voffB); PG8_STAGE(PG8_SB(0, 1), cB + hstep, voffB); PG8_STAGE(PG8_SA(0, 0), cA, voffA); PG8_STAGE(PG8_SA(0, 1), cA + hstep, voffA);
    if (wr == 1) PG8_BAR;
    PG8_WAIT_V(2); PG8_BAR;
    PG8_STAGE(PG8_SB(1, 0), cB + kstep, voffB); PG8_STAGE(PG8_SA(1, 0), cA + kstep, voffA); PG8_STAGE(PG8_SB(1, 1), cB + hstep + kstep, voffB);
    PG8_WAIT_V(6); PG8_BAR;
    for (;;) {
        const bool has_next = S.next(ui + 1, nxt);
        const char* nA = has_next ? (const char*)g.A + (size_t)nxt.pm * tstep : cA; const char* nB = has_next ? (const char*)g.Bt + (size_t)nxt.pn * tstep : cB;
        for (int t = 0; t < nt; t += 2) {
            const bool last = (t == nt - 2);
            const char* a1 = cA + (size_t)(t + 1) * kstep;
            const char* a2 = last ? nA : cA + (size_t)(t + 2) * kstep; const char* b2 = last ? nB : cB + (size_t)(t + 2) * kstep;
            const char* a3 = a2 + kstep; const char* b3 = b2 + kstep;
            if constexpr (Epi::HAS_MID) { if (t == (nt >> 1)) { if (wr == 0) PG8_BAR; E.mid(acc, cur, wr, wc, fr, fq); if (wr == 1) PG8_BAR; } }
            if (last && has_next) S.a_ready(nxt);
            PG8_LDB(B0, 0, 0); PG8_LDB(B1, 0, 1); PG8_SCHED; PG8_LDA(At, 0, 0); PG8_STAGE(PG8_SA(1, 1), a1 + hstep, voffA);
            PG8_WAIT_V(8); PG8_WAIT_L(0); PG8_BAR; PG8_MMA(0, 0, At, B0); PG8_MMA(0, 1, At, B1); PG8_BAR; PG8_SCHED;
            PG8_LDA(At, 0, 1); PG8_STAGE(PG8_SB(0, 0), b2, voffB); PG8_STAGE(PG8_SB(0, 1), b2 + hstep, voffB); PG8_STAGE(PG8_SA(0, 0), a2, voffA);
            PG8_WAIT_V(8); PG8_WAIT_L(0); PG8_BAR; PG8_MMA(1, 0, At, B0); PG8_MMA(1, 1, At, B1); PG8_BAR; PG8_SCHED;
            PG8_LDB(B0, 1, 0); PG8_LDB(B1, 1, 1); PG8_SCHED; PG8_LDA(At, 1, 0); PG8_STAGE(PG8_SA(0, 1), a2 + hstep, voffA);
            PG8_WAIT_V(8); PG8_WAIT_L(0); PG8_BAR; PG8_MMA(0, 0, At, B0); PG8_MMA(0, 1, At, B1); PG8_BAR; PG8_SCHED;
            PG8_LDA(At, 1, 1); PG8_STAGE(PG8_SB(1, 0), b3, voffB); PG8_STAGE(PG8_SB(1, 1), b3 + hstep, voffB); PG8_STAGE(PG8_SA(1, 0), a3, voffA);
            PG8_WAIT_V(8); PG8_WAIT_L(0); PG8_BAR; PG8_MMA(1, 0, At, B0); PG8_MMA(1, 1, At, B1); PG8_BAR; PG8_SCHED;
        }
        if (wr == 0) PG8_BAR;
        E(acc, cur, wr, wc, fr, fq); S.done(cur);
        if (!has_next) break;
#pragma unroll
        for (int a = 0; a < 2; ++a)
#pragma unroll
            for (int b = 0; b < 2; ++b)
#pragma unroll
                for (int m = 0; m < 4; ++m)
#pragma unroll
                    for (int n = 0; n < 2; ++n) acc[a][b][m][n] = (f32x4){0.f, 0.f, 0.f, 0.f};
        cur = nxt; cA = nA; cB = nB; ++ui;
        if (wr == 1) PG8_BAR;
    }
    PG8_WAIT_V(0);
    PG8_BAR;
#undef PG8_SA
#undef PG8_SB
#undef PG8_STAGE
#undef PG8_LDA
#undef PG8_LDB
#undef PG8_MMA
#undef PG8_WAIT_V
#undef PG8_WAIT_L
#undef PG8_BAR
#undef PG8_SCHED
}
}

using pg8::Unit;
typedef const f32x4 (&AccC)[2][2][4][2];
typedef f32x4 (&AccM)[2][2][4][2];

__device__ __forceinline__ void st8(bf16_t* p, const float (&v)[8]) {
    u32x4 w; w.x = cvt_pk_bf16(v[0], v[1]); w.y = cvt_pk_bf16(v[2], v[3]); w.z = cvt_pk_bf16(v[4], v[5]); w.w = cvt_pk_bf16(v[6], v[7]); *(u32x4*)p = w;
}
__device__ __forceinline__ void rope8(float (&v)[8], const float* cp, const float* sp) {
    const f32x4 c = *(const f32x4*)cp, s = *(const f32x4*)sp;
#pragma unroll
    for (int q = 0; q < 4; ++q) { const float x1 = v[2 * q], x2 = v[2 * q + 1]; v[2 * q] = x1 * c[q] - x2 * s[q]; v[2 * q + 1] = x1 * s[q] + x2 * c[q]; }
}

__device__ __forceinline__ void rope8v(float (&v)[8], const f32x4 c, const f32x4 s) {
#pragma unroll
    for (int q = 0; q < 4; ++q) { const float x1 = v[2 * q], x2 = v[2 * q + 1]; v[2 * q] = x1 * c[q] - x2 * s[q]; v[2 * q + 1] = x1 * s[q] + x2 * c[q]; }
}
struct EpiIn {
    static constexpr bool PERM = true, HAS_MID = false;
    const float* ssqx; const float* bias2; const float* cos_r; const float* sin_r; const float* cos_m; const float* sin_m;
    bf16_t *RQ, *RK, *RV, *SRG, *CQ, *CKV, *SMG, *GATE, *KB; float* ssqc;
    __device__ __forceinline__ void mid(AccM, const Unit&, int, int, int, int) const {}
    template <int MODE> __device__ __forceinline__ void body(AccC acc, const Unit& u, int wr, int wc, int fr, int fq) const {
        const int pn = u.pn, row0 = u.pm * 256 + wr * 64 + fr, b = u.pm >> 4, cl = wc * 32 + 8 * fq;
        float rinv[2][4];
#pragma unroll
        for (int ai = 0; ai < 2; ++ai)
#pragma unroll
            for (int m = 0; m < 4; ++m) { const float* sp = ssqx + (size_t)(row0 + ai * 128 + m * 16) * 32 + fq * 8; const f32x4 a = *(const f32x4*)sp, c = *(const f32x4*)(sp + 4);
                float s = ((a[0] + a[1]) + (a[2] + a[3])) + ((c[0] + c[1]) + (c[2] + c[3])); s = xadd16(s); s = xadd32(s); rinv[ai][m] = rsqrtf(s * (1.0f / 2048.0f) + EPS); }
        f32x4 bz[2][2];
#pragma unroll
        for (int bj = 0; bj < 2; ++bj) { const float* bp = bias2 + (size_t)b * DINP + pn * 256 + bj * 128 + cl; bz[bj][0] = *(const f32x4*)bp; bz[bj][1] = *(const f32x4*)(bp + 4); }
#pragma unroll
        for (int ai = 0; ai < 2; ++ai) {
            f32x4 rc[4], rs[4];
#pragma unroll
            for (int m = 0; m < 4; ++m) {
              if ((MODE == 0 || MODE == 5) && (m & 1) == 0) {
#pragma unroll
                for (int m2 = m; m2 < m + 2; ++m2) { const int m_ = m2; const size_t ro = (size_t)(row0 + ai * 128 + m_ * 16); rc[m_] = MODE == 0 ? *(const f32x4*)(cos_r + ro * 64 + (cl >> 1)) : *(const f32x4*)(cos_m + ro * 32 + ((cl & 63) >> 1));
                    rs[m_] = MODE == 0 ? *(const f32x4*)(sin_r + ro * 64 + (cl >> 1)) : *(const f32x4*)(sin_m + ro * 32 + ((cl & 63) >> 1)); }
              }
                const int row = row0 + ai * 128 + m * 16; const float r = rinv[ai][m];
                float ssq = 0.f;
#pragma unroll
                for (int bj = 0; bj < 2; ++bj) {
                    if (MODE == 5 && (bj != 0 || wc >= 2)) continue;
                    const int col = pn * 256 + bj * 128 + cl;
                    const f32x4 a0 = acc[ai][bj][m][0] * r + bz[bj][0], a1 = acc[ai][bj][m][1] * r + bz[bj][1];
                    float v[8] = {a0[0], a0[1], a0[2], a0[3], a1[0], a1[1], a1[2], a1[3]};
                    if (MODE == 0) {
                        rope8v(v, rc[m], rs[m]);
                        if (pn >= 4) {
#pragma unroll
                            for (int i = 0; i < 8; ++i) v[i] *= 0.08838834764831845f;
                        }
                        bf16_t* dst = (pn < 4 ? RQ : RK) + (size_t)row * 1024 + (pn & 3) * 256 + bj * 128 + cl; st8(dst, v);
                    } else if (MODE == 1) {
                        st8(RV + (size_t)row * 2048 + (col - 2048), v);
                    } else if (MODE == 2) {
#pragma unroll
                        for (int i = 0; i < 8; ++i) v[i] = silu_f(v[i]);
                        bf16_t* dst = (pn < 24) ? SRG + (size_t)row * 2048 + (col - 4096) : SMG + (size_t)row * 2048 + (col - 7168); st8(dst, v);
                    } else if (MODE == 3) {
#pragma unroll
                        for (int i = 0; i < 8; ++i) v[i] = sigmoid_f(v[i]);
                        st8(GATE + (size_t)row * 4096 + (col - 9216), v);
                    } else if (MODE == 4) {
#pragma unroll
                        for (int i = 0; i < 8; ++i) ssq += v[i] * v[i];
                        asm volatile("" : "+v"(ssq));
                        bf16_t* dst = (pn < 26) ? CQ + (size_t)row * 512 + (col - 6144) : CKV + (size_t)row * 512 + (col - 6656); st8(dst, v);
                    } else {
                        rope8v(v, rc[m], rs[m]);
                        bf16_t* dst = KB + (size_t)row * 3072 + 128 + cl;
                        u32x4 w; w.x = cvt_pk_bf16(v[0], v[1]); w.y = cvt_pk_bf16(v[2], v[3]); w.z = cvt_pk_bf16(v[4], v[5]); w.w = cvt_pk_bf16(v[6], v[7]);
#pragma unroll 1
                        for (int h = 0; h < 16; ++h) { *(u32x4*)dst = w; dst += 192; }
                    }
                }
                if (MODE == 4) { ssq = xadd16(ssq); ssq = xadd32(ssq); if (fq == 0) ssqc[(size_t)row * 16 + (pn - 24) * 4 + wc] = ssq; }
                asm volatile("" ::: "memory");
            }
        }
    }
    __device__ __forceinline__ void operator()(AccC acc, const Unit& u, int wr, int wc, int fr, int fq) const {
        { const int l_ = lane_opaque(); fr = l_ & 15; fq = l_ >> 4; }
        const int pn = u.pn;
        if (pn < 8) body<0>(acc, u, wr, wc, fr, fq);
        else if (pn < 16) body<1>(acc, u, wr, wc, fr, fq);
        else if (pn < 24) body<2>(acc, u, wr, wc, fr, fq);
        else if (pn < 28) body<4>(acc, u, wr, wc, fr, fq);
        else if (pn < 36) body<2>(acc, u, wr, wc, fr, fq);
        else if (pn < 52) body<3>(acc, u, wr, wc, fr, fq);
        else body<5>(acc, u, wr, wc, fr, fq);
    }
};

template <int KV> struct EpiUp {
    static constexpr bool PERM = true, HAS_MID = false;
    const float* ssqc; const float* cos_m; const float* sin_m; bf16_t* QB; bf16_t* KB; bf16_t* VB;
    __device__ __forceinline__ void mid(AccM, const Unit&, int, int, int, int) const {}
    __device__ __forceinline__ void operator()(AccC acc, const Unit& u, int wr, int wc, int fr, int fq) const {
        { const int l_ = lane_opaque(); fr = l_ & 15; fq = l_ >> 4; }
        const int pn = u.pn, row0 = u.pm * 256 + wr * 64 + fr, cl = wc * 32 + 8 * fq;
        float rinv[2][4];
#pragma unroll
        for (int ai = 0; ai < 2; ++ai)
#pragma unroll
            for (int m = 0; m < 4; ++m) { const float* sp = ssqc + (size_t)(row0 + ai * 128 + m * 16) * 16 + KV * 8; const f32x4 a = *(const f32x4*)sp, c = *(const f32x4*)(sp + 4);
                const float s = ((a[0] + a[1]) + (a[2] + a[3])) + ((c[0] + c[1]) + (c[2] + c[3])); rinv[ai][m] = rsqrtf(s * (1.0f / 512.0f) + EPS); }
#pragma unroll
        for (int bj = 0; bj < 2; ++bj)
#pragma unroll
            for (int ai = 0; ai < 2; ++ai)
#pragma unroll
                for (int m = 0; m < 4; ++m) {
                    const int row = row0 + ai * 128 + m * 16; const float r = rinv[ai][m];
                    const f32x4 a0 = acc[ai][bj][m][0] * r, a1 = acc[ai][bj][m][1] * r;
                    float v[8] = {a0[0], a0[1], a0[2], a0[3], a1[0], a1[1], a1[2], a1[3]};
                    if (KV == 0) {
                        if (pn < 8) { st8(QB + (size_t)row * 3072 + (pn * 2 + bj) * 192 + cl, v); }
                        else { const int rr = (pn - 8) * 256 + bj * 128 + cl, h = rr >> 6, p = rr & 63;
                            rope8(v, cos_m + (size_t)row * 32 + (p >> 1), sin_m + (size_t)row * 32 + (p >> 1));
                            st8(QB + (size_t)row * 3072 + h * 192 + 128 + p, v); }
                    } else {
                        if (pn < 8) st8(KB + (size_t)row * 3072 + (pn * 2 + bj) * 192 + cl, v);
                        else st8(VB + (size_t)row * 2048 + (pn - 8) * 256 + bj * 128 + cl, v);
                    }
                    asm volatile("" ::: "memory");
                }
    }
};

struct EpiMerge {
    static constexpr bool PERM = true, HAS_MID = true;
    const bf16_t* GATE; bf16_t* MERGED;
    __device__ __forceinline__ void mid(AccM acc, const Unit& u, int wr, int wc, int fr, int fq) const {
        { const int l_ = lane_opaque(); fr = l_ & 15; fq = l_ >> 4; }
        const int row0 = u.pm * 256 + wr * 64 + fr, cl = wc * 32 + 8 * fq;
#pragma unroll
        for (int ai = 0; ai < 2; ++ai)
#pragma unroll
            for (int mp = 0; mp < 2; ++mp) {
                u32x4 ga[2][2], gb[2][2];
#pragma unroll
                for (int mm = 0; mm < 2; ++mm)
#pragma unroll
                    for (int bj = 0; bj < 2; ++bj) { const bf16_t* gp = GATE + (size_t)(row0 + ai * 128 + (2 * mp + mm) * 16) * 4096 + u.pn * 256 + bj * 128 + cl; ga[mm][bj] = *(const u32x4*)gp; gb[mm][bj] = *(const u32x4*)(gp + 2048); }
#pragma unroll
                for (int mm = 0; mm < 2; ++mm)
#pragma unroll
                    for (int bj = 0; bj < 2; ++bj) { const int m = 2 * mp + mm; const u32x4 a = ga[mm][bj], b = gb[mm][bj]; f32x4 r0, r1;
                        r0[0] = bf_lo(a.x) * __builtin_amdgcn_rcpf(bf_lo(b.x)); r0[1] = bf_hi(a.x) * __builtin_amdgcn_rcpf(bf_hi(b.x));
                        r0[2] = bf_lo(a.y) * __builtin_amdgcn_rcpf(bf_lo(b.y)); r0[3] = bf_hi(a.y) * __builtin_amdgcn_rcpf(bf_hi(b.y));
                        r1[0] = bf_lo(a.z) * __builtin_amdgcn_rcpf(bf_lo(b.z)); r1[1] = bf_hi(a.z) * __builtin_amdgcn_rcpf(bf_hi(b.z));
                        r1[2] = bf_lo(a.w) * __builtin_amdgcn_rcpf(bf_lo(b.w)); r1[3] = bf_hi(a.w) * __builtin_amdgcn_rcpf(bf_hi(b.w));
                        acc[ai][bj][m][0] *= r0; acc[ai][bj][m][1] *= r1; }
                asm volatile("" ::: "memory");
            }
    }
    __device__ __forceinline__ void operator()(AccC acc, const Unit& u, int wr, int wc, int fr, int fq) const {
        { const int l_ = lane_opaque(); fr = l_ & 15; fq = l_ >> 4; }
        const int row0 = u.pm * 256 + wr * 64 + fr, cl = wc * 32 + 8 * fq;
#pragma unroll
        for (int ai = 0; ai < 2; ++ai)
#pragma unroll
            for (int m = 0; m < 4; ++m) {
#pragma unroll
                for (int bj = 0; bj < 2; ++bj) {
                    const size_t off = (size_t)(row0 + ai * 128 + m * 16);
                    const int col = u.pn * 256 + bj * 128 + cl;
                    const u32x4 gb = *(const u32x4*)(GATE + off * 4096 + 2048 + col);
                    const f32x4 a0 = acc[ai][bj][m][0], a1 = acc[ai][bj][m][1];
                    float v[8] = {a0[0] * bf_lo(gb.x), a0[1] * bf_hi(gb.x), a0[2] * bf_lo(gb.y), a0[3] * bf_hi(gb.y), a1[0] * bf_lo(gb.z), a1[1] * bf_hi(gb.z), a1[2] * bf_lo(gb.w), a1[3] * bf_hi(gb.w)};
                    st8(MERGED + off * 2048 + col, v);
                    asm volatile("" ::: "memory");
                }
            }
    }
};

struct EpiOut {
    static constexpr bool PERM = false, HAS_MID = false;
    const float* xin; float* xout; const float* gate;   const float* gnorm_next; const float* scale_next;
    bf16_t* XG; float* ssqx;
    __device__ __forceinline__ void mid(AccM, const Unit&, int, int, int, int) const {}
    __device__ __forceinline__ void operator()(AccC acc, const Unit& u, int wr, int wc, int fr, int fq) const {
        { const int l_ = lane_opaque(); fr = l_ & 15; fq = l_ >> 4; }
        const int row0 = u.pm * 256 + wr * 64 + fr, b = u.pm >> 4, col0 = u.pn * 256 + wc * 32 + 4 * fq;
        f32x4 gt[2][2], gn[2][2];
#pragma unroll
        for (int bj = 0; bj < 2; ++bj)
#pragma unroll
            for (int n = 0; n < 2; ++n) { const int col = col0 + bj * 128 + n * 16; gt[bj][n] = *(const f32x4*)(gate + (size_t)b * 6144 + col);
                const f32x4 g = *(const f32x4*)(gnorm_next + col), s = *(const f32x4*)(scale_next + (size_t)b * 6144 + col); gn[bj][n] = g * (s + 1.0f); }
#pragma unroll
        for (int ai = 0; ai < 2; ++ai)
#pragma unroll
            for (int m = 0; m < 4; ++m) {
                const int row = row0 + ai * 128 + m * 16; float ss = 0.f; const size_t off0 = (size_t)row * 2048 + col0;
                f32x4 xo[2][2];
#pragma unroll
                for (int bj = 0; bj < 2; ++bj)
#pragma unroll
                    for (int n = 0; n < 2; ++n) xo[bj][n] = *(const f32x4*)(xin + off0 + bj * 128 + n * 16);
#pragma unroll
                for (int bj = 0; bj < 2; ++bj)
#pragma unroll
                    for (int n = 0; n < 2; ++n) { const size_t off = off0 + bj * 128 + n * 16;
                        const f32x4 xn = xo[bj][n] + gt[bj][n] * acc[ai][bj][m][n];
                        *(f32x4*)(xout + off) = xn; ss += (xn[0] * xn[0] + xn[1] * xn[1]) + (xn[2] * xn[2] + xn[3] * xn[3]);
                        if (XG) { const f32x4 y = xn * gn[bj][n]; u32x2 w; w.x = cvt_pk_bf16(y[0], y[1]); w.y = cvt_pk_bf16(y[2], y[3]); *(u32x2*)(XG + off) = w; } }
                ss = xadd16(ss); ss = xadd32(ss);
                if (fq == 0) ssqx[(size_t)row * 32 + u.pn * 4 + wc] = ss;
                asm volatile("" ::: "memory");
            }
    }
};

namespace att {
constexpr int KVBLK = 64, QBLK = 32;
constexpr float SCALE = 0.07216878364870322f;
constexpr float THR = 8.f;
constexpr int LDQ = 3072, LDK = 3072, LDV = 2048;
constexpr int SHM_V = KVBLK * 128 * 2, SHM_K = KVBLK * 192 * 2;
#define KSWZ(row, colB) ((row) * 384 + ((colB) ^ (((row) & 7) << 4)))
#define SBAR() __builtin_amdgcn_sched_barrier(0)
__device__ __forceinline__ int crow(int r, int hi) { return (r & 3) + 8 * (r >> 2) + 4 * hi; }

__device__ __forceinline__ void partialSM(f32x16& p0, f32x16& p1, float& m_reg, float& mn, float& alpha) {
  constexpr float C = SCALE * 1.4426950408889634f;
  float pmax = p0[0];
#pragma unroll
  for (int r = 1; r < 16; ++r) pmax = fmaxf(pmax, p0[r]);
#pragma unroll
  for (int r = 0; r < 16; ++r) pmax = fmaxf(pmax, p1[r]);
  { auto rr = __builtin_amdgcn_permlane32_swap(__float_as_uint(pmax), __float_as_uint(pmax), false, false);
    pmax = fmaxf(__uint_as_float(rr[0]), __uint_as_float(rr[1])); }
  if (__builtin_expect(__all(pmax - m_reg <= THR / SCALE), 1)) { mn = m_reg; alpha = 1.f; }
  else { mn = fmaxf(m_reg, pmax); alpha = __builtin_amdgcn_exp2f((m_reg - mn) * C); m_reg = mn; }
  float mnC = -mn * C;
#pragma unroll
  for (int r = 0; r < 16; ++r) p0[r] = fmaf(p0[r], C, mnC);
#pragma unroll
  for (int r = 0; r < 16; ++r) p1[r] = fmaf(p1[r], C, mnC);
#pragma unroll
  for (int r = 0; r < 16; ++r) p0[r] = __builtin_amdgcn_exp2f(p0[r]);
}
__device__ __forceinline__ void finishSM(f32x16& p0, f32x16& p1, float alpha, float& l_reg, bf16x8& pa0, bf16x8& pa1, bf16x8& pa2, bf16x8& pa3) {
#pragma unroll
  for (int r = 0; r < 16; ++r) p1[r] = __builtin_amdgcn_exp2f(p1[r]);
  float ps = 0;
#pragma unroll
  for (int r = 0; r < 16; ++r) ps += p0[r];
#pragma unroll
  for (int r = 0; r < 16; ++r) ps += p1[r];
  { auto rr = __builtin_amdgcn_permlane32_swap(__float_as_uint(ps), __float_as_uint(ps), false, false);
    ps = __uint_as_float(rr[0]) + __uint_as_float(rr[1]); }
  l_reg = l_reg * alpha + ps;
#define PK4(P, BASE, OUT) do { unsigned a0 = cvt_pk_bf16(P[BASE + 0], P[BASE + 1]), a1 = cvt_pk_bf16(P[BASE + 2], P[BASE + 3]);   \
    unsigned b0 = cvt_pk_bf16(P[BASE + 4], P[BASE + 5]), b1 = cvt_pk_bf16(P[BASE + 6], P[BASE + 7]);                              \
    auto r0 = __builtin_amdgcn_permlane32_swap(a0, b0, false, false); auto r1 = __builtin_amdgcn_permlane32_swap(a1, b1, false, false); \
    u32x4 w = {r0[0], r1[0], r0[1], r1[1]}; OUT = *reinterpret_cast<bf16x8*>(&w); } while (0)
  PK4(p0, 0, pa0); PK4(p0, 8, pa1); PK4(p1, 0, pa2); PK4(p1, 8, pa3);
#undef PK4
}
__device__ __forceinline__ void qkt(f32x16& p0, f32x16& p1, const char* Ks, const bf16x8* qr, int r32, int hi) {
  p0 = f32x16{}; p1 = f32x16{};
#pragma unroll
  for (int d0 = 0; d0 < 12; ++d0) { int cb = (d0 * 16 + hi * 8) * 2;
    bf16x8 b0 = *reinterpret_cast<const bf16x8*>(Ks + KSWZ(r32, cb));
    bf16x8 b1 = *reinterpret_cast<const bf16x8*>(Ks + KSWZ(32 + r32, cb));
    p0 = __builtin_amdgcn_mfma_f32_32x32x16_bf16(b0, qr[d0], p0, 0, 0, 0);
    p1 = __builtin_amdgcn_mfma_f32_32x32x16_bf16(b1, qr[d0], p1, 0, 0, 0); }
}
__device__ __forceinline__ int v_st(int k, int c) { const int kk = (k & ~0xC) | ((k & 4) << 1) | ((k & 8) >> 1); return ((kk >> 3) * 4 + (c >> 5)) * 512 + ((kk & 7) * 32 + (c & 31)) * 2; }
__device__ __forceinline__ int v_rd_base(int lane) { return ((lane & 3) << 3) | (((lane >> 2) & 3) << 6) | (((lane >> 4) & 1) << 5) | (((lane >> 5) & 1) << 8); }
constexpr int v_rd_off(int d0, int ks, int half) { return d0 * 512 + ks * 4096 + half * 2048; }
template <int OFF> __device__ __forceinline__ s16x4 tr_read(int vb) {
  s16x4 r; asm volatile("ds_read_b64_tr_b16 %0, %1 offset:%2" : "=&v"(r) : "v"(vb), "i"(OFF) : "memory"); return r;
}
template <int D0> __device__ __forceinline__ void pv_one(f32x16& od, int vb, bf16x8 pa0, bf16x8 pa1, bf16x8 pa2, bf16x8 pa3) {
  const s16x4 l0 = tr_read<v_rd_off(D0, 0, 0)>(vb), h0 = tr_read<v_rd_off(D0, 0, 1)>(vb), l1 = tr_read<v_rd_off(D0, 1, 0)>(vb), h1 = tr_read<v_rd_off(D0, 1, 1)>(vb);
  const s16x4 l2 = tr_read<v_rd_off(D0, 2, 0)>(vb), h2 = tr_read<v_rd_off(D0, 2, 1)>(vb), l3 = tr_read<v_rd_off(D0, 3, 0)>(vb), h3 = tr_read<v_rd_off(D0, 3, 1)>(vb);
  asm volatile("s_waitcnt lgkmcnt(0)" ::: "memory"); SBAR();
#define PK(L, H) (bf16x8){L[0], L[1], L[2], L[3], H[0], H[1], H[2], H[3]}
  od = __builtin_amdgcn_mfma_f32_32x32x16_bf16(pa0, PK(l0, h0), od, 0, 0, 0);
  od = __builtin_amdgcn_mfma_f32_32x32x16_bf16(pa1, PK(l1, h1), od, 0, 0, 0);
  od = __builtin_amdgcn_mfma_f32_32x32x16_bf16(pa2, PK(l2, h2), od, 0, 0, 0);
  od = __builtin_amdgcn_mfma_f32_32x32x16_bf16(pa3, PK(l3, h3), od, 0, 0, 0);
#undef PK
}
__device__ __forceinline__ void pv_d0(f32x16* o, int vb, bf16x8 pa0, bf16x8 pa1, bf16x8 pa2, bf16x8 pa3) {
  pv_one<0>(o[0], vb, pa0, pa1, pa2, pa3); pv_one<1>(o[1], vb, pa0, pa1, pa2, pa3); pv_one<2>(o[2], vb, pa0, pa1, pa2, pa3); pv_one<3>(o[3], vb, pa0, pa1, pa2, pa3);
}

__device__ __forceinline__ void attn_item(const bf16_t* __restrict__ Qb, const bf16_t* __restrict__ Kh, const bf16_t* __restrict__ Vh, bf16_t* __restrict__ Ob, const bf16_t* __restrict__ Gb, int qb, char* lds) {
  const int tid = tid_opaque(), wid = tid >> 6, lane = tid & 63, r32 = lane & 31, hi = lane >> 5;
  char* V_lds = lds; char* K_lds = lds + 2 * SHM_V;
  float* wsl = (float*)(lds + 2 * SHM_V + 2 * SHM_K) + wid * 64; float* li_l = wsl; float* al_l = wsl + 32;
  float m_reg = -1e30f, l_reg = 0; f32x16 o[4] = {}; bf16x8 qr[12];
  const bf16_t* Qw = Qb + (size_t)(wid * QBLK + r32) * LDQ + hi * 8;
#pragma unroll
  for (int d0 = 0; d0 < 12; ++d0) qr[d0] = *reinterpret_cast<const bf16x8*>(Qw + d0 * 16);
  const int sr = tid >> 4, sc = (tid & 15) * 8, vst0 = v_st(sr, sc), vst1 = v_st(32 + sr, sc);
  int kgo[3], klo[3];
#pragma unroll
  for (int i = 0; i < 3; ++i) { const int q = tid + 512 * i, kr_ = q / 24, kc_ = (q % 24) * 8; kgo[i] = kr_ * LDK + kc_; klo[i] = KSWZ(kr_, kc_ * 2); }
  const int vgo = sr * LDV + sc;
  const int vb0 = (int)(uintptr_t)V_lds + v_rd_base(lane);
  bf16x8 vs0, vs1, ks0, ks1, ks2;
  const int NT = 4 * qb + 4, cwt = 4 * qb + (wid >> 1);
#define SLOAD(k0) do { const bf16_t* vp_ = Vh + (size_t)(k0) * LDV + vgo; const bf16_t* kp_ = Kh + (size_t)(k0) * LDK; \
    vs0 = *reinterpret_cast<const bf16x8*>(vp_); vs1 = *reinterpret_cast<const bf16x8*>(vp_ + 32 * LDV); \
    ks0 = *reinterpret_cast<const bf16x8*>(kp_ + kgo[0]); ks1 = *reinterpret_cast<const bf16x8*>(kp_ + kgo[1]); ks2 = *reinterpret_cast<const bf16x8*>(kp_ + kgo[2]); } while (0)
#define SWRITE(b) do { *(bf16x8*)(V_lds + (b) * SHM_V + vst0) = vs0; *(bf16x8*)(V_lds + (b) * SHM_V + vst1) = vs1; \
    *(bf16x8*)(K_lds + (b) * SHM_K + klo[0]) = ks0; *(bf16x8*)(K_lds + (b) * SHM_K + klo[1]) = ks1; *(bf16x8*)(K_lds + (b) * SHM_K + klo[2]) = ks2; } while (0)
#define SWAIT() asm volatile("s_waitcnt vmcnt(0)" ::: "memory")
#define RESC(a) do { if (__any((a) < 1.f)) { if (hi == 0) al_l[r32] = (a); asm volatile("s_waitcnt lgkmcnt(0)" ::: "memory"); \
    _Pragma("unroll") for (int d = 0; d < 4; ++d) _Pragma("unroll") for (int r = 0; r < 16; ++r) o[d][r] *= al_l[crow(r, hi)]; } } while (0)
#define QKT(P0, P1, KB_, j) do { if ((j) <= cwt) qkt(P0, P1, KB_, qr, r32, hi); else { _Pragma("unroll") for (int r_ = 0; r_ < 16; ++r_) { P0[r_] = -1e30f; P1[r_] = -1e30f; } } } while (0)
#define PV(vb_, j) do { if ((j) <= cwt) pv_d0(o, vb_, pa0, pa1, pa2, pa3); } while (0)
  f32x16 pA0, pA1, pB0, pB1; float mnA, mnB, alA, alB; bf16x8 pa0, pa1, pa2, pa3;
  SLOAD(0); SWAIT(); SWRITE(0); __syncthreads();
  QKT(pA0, pA1, K_lds, 0); partialSM(pA0, pA1, m_reg, mnA, alA);
  SLOAD(KVBLK);
  SWAIT(); SWRITE(1); __syncthreads();
  for (int j = 1; j + 1 < NT; j += 2) {
    SBAR(); QKT(pB0, pB1, K_lds + SHM_K, j);
    finishSM(pA0, pA1, alA, l_reg, pa0, pa1, pa2, pa3); SBAR();
    SLOAD((j + 1) * KVBLK); SBAR();
    PV(vb0, j - 1); partialSM(pB0, pB1, m_reg, mnB, alB);
    __syncthreads(); SWAIT(); SWRITE(0);
    RESC(alB); __syncthreads();
    SBAR(); QKT(pA0, pA1, K_lds, j + 1);
    finishSM(pB0, pB1, alB, l_reg, pa0, pa1, pa2, pa3); SBAR();
    SLOAD((j + 2) * KVBLK); SBAR();
    PV(vb0 + SHM_V, j); partialSM(pA0, pA1, m_reg, mnA, alA);
    __syncthreads(); SWAIT(); SWRITE(1);
    RESC(alA); __syncthreads();
  }
  SBAR(); QKT(pB0, pB1, K_lds + SHM_K, NT - 1);
  finishSM(pA0, pA1, alA, l_reg, pa0, pa1, pa2, pa3); SBAR();
  PV(vb0, NT - 2); partialSM(pB0, pB1, m_reg, mnB, alB);
  __syncthreads(); RESC(alB);
  finishSM(pB0, pB1, alB, l_reg, pa0, pa1, pa2, pa3); SBAR();
  PV(vb0 + SHM_V, NT - 1);
  if (hi == 0) li_l[r32] = l_reg; asm volatile("s_waitcnt lgkmcnt(0)" ::: "memory");
  __syncthreads();
  char* ot = lds + wid * 8192;
#pragma unroll
  for (int r = 0; r < 16; ++r) { const int orow = crow(r, hi); const float rl = __builtin_amdgcn_rcpf(li_l[orow]);
#pragma unroll
    for (int d0 = 0; d0 < 4; ++d0) *(bf16_t*)(ot + orow * 256 + (d0 * 32 + r32) * 2) = f2bf(o[d0][r] * rl);
    asm volatile("" ::: "memory"); }
  asm volatile("s_waitcnt lgkmcnt(0)" ::: "memory");
  const int ln2 = lane_opaque();
#pragma unroll
  for (int i = 0; i < 8; ++i) { const int orow = i * 4 + (ln2 >> 4), ch = ln2 & 15; const size_t grow = (size_t)(wid * QBLK + orow);
    const u32x4 ov = *(const u32x4*)(ot + orow * 256 + ch * 16); const u32x4 gv = *(const u32x4*)(Gb + grow * 2048 + ch * 8);
    u32x4 w; w.x = cvt_pk_bf16(bf_lo(ov.x) * bf_lo(gv.x), bf_hi(ov.x) * bf_hi(gv.x)); w.y = cvt_pk_bf16(bf_lo(ov.y) * bf_lo(gv.y), bf_hi(ov.y) * bf_hi(gv.y));
    w.z = cvt_pk_bf16(bf_lo(ov.z) * bf_lo(gv.z), bf_hi(ov.z) * bf_hi(gv.z)); w.w = cvt_pk_bf16(bf_lo(ov.w) * bf_lo(gv.w), bf_hi(ov.w) * bf_hi(gv.w));
    *(u32x4*)(Ob + grow * 4096 + ch * 8) = w; if (i & 1) asm volatile("" ::: "memory"); }
  __syncthreads();
#undef SLOAD
#undef SWRITE
#undef SWAIT
#undef RESC
#undef QKT
#undef PV
}
}

namespace ret {
constexpr int QS_STRIDE = 272, T_STRIDE = 144;
constexpr int OFF_QS = 0, OFF_KS = 64 * QS_STRIDE, OFF_KZ = OFF_KS + 64 * QS_STRIDE, OFF_V = OFF_KZ + 16384, OFF_SP = OFF_V + 32768, OFF_ST = OFF_SP + 64 * T_STRIDE, OFF_END = OFF_ST + 8 * 64 * 8;
static_assert(OFF_END <= LDS_BYTES - 16, "retention LDS");
__device__ __forceinline__ int crow(int r, int hi) { return (r & 3) + 8 * (r >> 2) + 4 * hi; }
template <int KS> __device__ __forceinline__ bf16x8 tfrag(int vb) {
  const s16x4 l = att::tr_read<KS * 4096>(vb), h = att::tr_read<KS * 4096 + 2048>(vb);
  asm volatile("s_waitcnt lgkmcnt(0)" ::: "memory"); __builtin_amdgcn_sched_barrier(0);
  return (bf16x8){l[0], l[1], l[2], l[3], h[0], h[1], h[2], h[3]};
}

__device__ __forceinline__ void worker(const bf16_t* __restrict__ RQ, const bf16_t* __restrict__ RK, const bf16_t* __restrict__ RV, const bf16_t* __restrict__ SRG, bf16_t* __restrict__ AR, int b, int h, char* lds) {
  const int tid = tid_opaque(), wid = tid >> 6, lane = tid & 63, r32 = lane & 31, hi = lane >> 5, fr = lane & 15, fq = lane >> 4;
  char* Qs = lds + OFF_QS; char* Ks = lds + OFF_KS; char* Kz = lds + OFF_KZ; char* Vt = lds + OFF_V; char* Sp = lds + OFF_SP; float* St = (float*)(lds + OFF_ST);
  const float lg2 = log2f(1.0f - exp2f(-5.0f - (float)h));
  const int sr = tid >> 4, sc = (tid & 15) * 8;
  const int vst0 = att::v_st(sr, sc), vst1 = att::v_st(32 + sr, sc);
  const float zeta0 = exp2f((float)(63 - sr) * lg2), zeta1 = exp2f((float)(31 - sr) * lg2), dchunk = exp2f(64.0f * lg2);
  float xi[2]; xi[0] = exp2f((float)(r32 + 1) * lg2); xi[1] = exp2f((float)(32 + r32 + 1) * lg2);
  const int kzb = (int)(uintptr_t)Kz + att::v_rd_base(lane);
  const int vtb = (int)(uintptr_t)Vt + (wid >> 2) * 16384 + att::v_rd_base(lane) + (wid & 3) * 512;
  f32x16 R[4];
#pragma unroll
  for (int d = 0; d < 4; ++d) R[d] = f32x16{};
  bf16x8 pq[2], pk[2], pv[4]; u32x2 pg[2][4];
  const size_t tok0 = (size_t)b * SEQ;
#define RLOAD(n) do { const size_t t0_ = tok0 + (size_t)(n) * 64 + sr, t1_ = t0_ + 32; \
    pq[0] = *reinterpret_cast<const bf16x8*>(RQ + t0_ * 1024 + h * 128 + sc); pq[1] = *reinterpret_cast<const bf16x8*>(RQ + t1_ * 1024 + h * 128 + sc); \
    pk[0] = *reinterpret_cast<const bf16x8*>(RK + t0_ * 1024 + h * 128 + sc); pk[1] = *reinterpret_cast<const bf16x8*>(RK + t1_ * 1024 + h * 128 + sc); \
    pv[0] = *reinterpret_cast<const bf16x8*>(RV + t0_ * 2048 + h * 256 + sc); pv[1] = *reinterpret_cast<const bf16x8*>(RV + t1_ * 2048 + h * 256 + sc); \
    pv[2] = *reinterpret_cast<const bf16x8*>(RV + t0_ * 2048 + h * 256 + 128 + sc); pv[3] = *reinterpret_cast<const bf16x8*>(RV + t1_ * 2048 + h * 256 + 128 + sc); } while (0)
#define GLOAD(n) do { _Pragma("unroll") for (int it_ = 0; it_ < 2; ++it_) _Pragma("unroll") for (int g_ = 0; g_ < 4; ++g_) pg[it_][g_] = *(const u32x2*)(SRG + (tok0 + (size_t)(n) * 64 + 32 * it_ + r32) * 2048 + h * 256 + 32 * wid + 8 * g_ + 4 * hi); } while (0)
#define STAGE() do { \
    *(bf16x8*)(Qs + sr * QS_STRIDE + sc * 2) = pq[0]; *(bf16x8*)(Qs + (32 + sr) * QS_STRIDE + sc * 2) = pq[1]; \
    *(bf16x8*)(Ks + sr * QS_STRIDE + sc * 2) = pk[0]; *(bf16x8*)(Ks + (32 + sr) * QS_STRIDE + sc * 2) = pk[1]; \
    { float z[8]; u32x4 w; \
_Pragma("unroll") \
      for (int t = 0; t < 8; ++t) z[t] = bf2f((bf16_t)pk[0][t]) * zeta0; \
      w.x = cvt_pk_bf16(z[0], z[1]); w.y = cvt_pk_bf16(z[2], z[3]); w.z = cvt_pk_bf16(z[4], z[5]); w.w = cvt_pk_bf16(z[6], z[7]); *(u32x4*)(Kz + vst0) = w; \
_Pragma("unroll") \
      for (int t = 0; t < 8; ++t) z[t] = bf2f((bf16_t)pk[1][t]) * zeta1; \
      w.x = cvt_pk_bf16(z[0], z[1]); w.y = cvt_pk_bf16(z[2], z[3]); w.z = cvt_pk_bf16(z[4], z[5]); w.w = cvt_pk_bf16(z[6], z[7]); *(u32x4*)(Kz + vst1) = w; } \
    *(bf16x8*)(Vt + vst0) = pv[0]; *(bf16x8*)(Vt + vst1) = pv[1]; *(bf16x8*)(Vt + 16384 + vst0) = pv[2]; *(bf16x8*)(Vt + 16384 + vst1) = pv[3]; } while (0)
  RLOAD(0); STAGE();
  for (int n = 0; n < 64; ++n) {
    __syncthreads();
    { const int n1 = n + 1 < 64 ? n + 1 : 63; RLOAD(n1); }
    GLOAD(n);
    {
      const int ti = wid >> 1, tj0 = (wid & 1) * 2;
      f32x4 s0 = {0.f, 0.f, 0.f, 0.f}, s1 = {0.f, 0.f, 0.f, 0.f};
#pragma unroll
      for (int kk = 0; kk < 4; ++kk) {
        const bf16x8 bq = *(const bf16x8*)(Qs + (ti * 16 + fr) * QS_STRIDE + (kk * 32 + fq * 8) * 2);
        const bf16x8 a0 = *(const bf16x8*)(Ks + (tj0 * 16 + fr) * QS_STRIDE + (kk * 32 + fq * 8) * 2);
        const bf16x8 a1 = *(const bf16x8*)(Ks + ((tj0 + 1) * 16 + fr) * QS_STRIDE + (kk * 32 + fq * 8) * 2);
        s0 = __builtin_amdgcn_mfma_f32_16x16x32_bf16(a0, bq, s0, 0, 0, 0);
        s1 = __builtin_amdgcn_mfma_f32_16x16x32_bf16(a1, bq, s1, 0, 0, 0);
      }
      const int it = ti * 16 + fr;
#pragma unroll
      for (int t2 = 0; t2 < 2; ++t2) { const int jb = (tj0 + t2) * 16 + 4 * fq; const f32x4 s = t2 ? s1 : s0; float w[4];
#pragma unroll
        for (int r = 0; r < 4; ++r) { const int dd = it - (jb + r); w[r] = s[r] * exp2f((float)(dd < 0 ? -dd : dd) * lg2); }
        u32x2 pk2; pk2.x = cvt_pk_bf16(w[0], w[1]); pk2.y = cvt_pk_bf16(w[2], w[3]); *(u32x2*)(Sp + it * T_STRIDE + jb * 2) = pk2; }
    }
    __syncthreads();
    f32x16 oc[2]; oc[0] = f32x16{}; oc[1] = f32x16{};
#pragma unroll
    for (int dt = 0; dt < 4; ++dt)
#pragma unroll
      for (int sp = 0; sp < 2; ++sp) {
        u32x4 aw; aw.x = cvt_pk_bf16(R[dt][8 * sp + 0], R[dt][8 * sp + 1]); aw.y = cvt_pk_bf16(R[dt][8 * sp + 2], R[dt][8 * sp + 3]);
        aw.z = cvt_pk_bf16(R[dt][8 * sp + 4], R[dt][8 * sp + 5]); aw.w = cvt_pk_bf16(R[dt][8 * sp + 6], R[dt][8 * sp + 7]);
        const bf16x8 A = *reinterpret_cast<bf16x8*>(&aw);
#pragma unroll
        for (int it = 0; it < 2; ++it) { const char* bp = Qs + (32 * it + r32) * QS_STRIDE + (32 * dt + 16 * sp + 4 * hi) * 2;
          const s16x4 lo = *(const s16x4*)bp, h4 = *(const s16x4*)(bp + 16);
          const bf16x8 B = (bf16x8){lo[0], lo[1], lo[2], lo[3], h4[0], h4[1], h4[2], h4[3]};
          oc[it] = __builtin_amdgcn_mfma_f32_32x32x16_bf16(A, B, oc[it], 0, 0, 0); }
      }
#pragma unroll
    for (int it = 0; it < 2; ++it)
#pragma unroll
      for (int r = 0; r < 16; ++r) oc[it][r] *= xi[it];
    bf16x8 vfr[4]; vfr[0] = tfrag<0>(vtb); vfr[1] = tfrag<1>(vtb); vfr[2] = tfrag<2>(vtb); vfr[3] = tfrag<3>(vtb);
#pragma unroll
    for (int it = 0; it < 2; ++it)
#pragma unroll
      for (int ks = 0; ks < 4; ++ks) { const bf16x8 B = *(const bf16x8*)(Sp + (32 * it + r32) * T_STRIDE + (16 * ks + 8 * hi) * 2);
        oc[it] = __builtin_amdgcn_mfma_f32_32x32x16_bf16(vfr[ks], B, oc[it], 0, 0, 0); }
#pragma unroll
    for (int dt = 0; dt < 4; ++dt) {
#pragma unroll
      for (int r = 0; r < 16; ++r) R[dt][r] *= dchunk;
      const int kb = kzb + dt * 512;
      R[dt] = __builtin_amdgcn_mfma_f32_32x32x16_bf16(tfrag<0>(kb), tfrag<0>(vtb), R[dt], 0, 0, 0);
      R[dt] = __builtin_amdgcn_mfma_f32_32x32x16_bf16(tfrag<1>(kb), tfrag<1>(vtb), R[dt], 0, 0, 0);
      R[dt] = __builtin_amdgcn_mfma_f32_32x32x16_bf16(tfrag<2>(kb), tfrag<2>(vtb), R[dt], 0, 0, 0);
      R[dt] = __builtin_amdgcn_mfma_f32_32x32x16_bf16(tfrag<3>(kb), tfrag<3>(vtb), R[dt], 0, 0, 0);
    }
#pragma unroll
    for (int it = 0; it < 2; ++it) { float s1 = 0.f, s2 = 0.f;
#pragma unroll
      for (int r = 0; r < 16; ++r) { s1 += oc[it][r]; s2 += oc[it][r] * oc[it][r]; }
      s1 = xadd32(s1); s2 = xadd32(s2);
      if (hi == 0) *(f32x2*)(St + (wid * 64 + 32 * it + r32) * 2) = (f32x2){s1, s2}; }
    __syncthreads();
#pragma unroll
    for (int it = 0; it < 2; ++it) { float S1 = 0.f, S2 = 0.f;
#pragma unroll
      for (int w = 0; w < 8; ++w) { const f32x2 v = *(const f32x2*)(St + (w * 64 + 32 * it + r32) * 2); S1 += v.x; S2 += v.y; }
      const float mu = S1 * (1.0f / 256.0f), var = S2 * (1.0f / 256.0f) - mu * mu, rstd = rsqrtf(fmaxf(var, 0.f) + EPS);
      const size_t t = tok0 + (size_t)n * 64 + 32 * it + r32;
#pragma unroll
      for (int g = 0; g < 4; ++g) { const int e = h * 256 + 32 * wid + 8 * g + 4 * hi;
        const u32x2 gw = pg[it][g];
        u32x2 ow; ow.x = cvt_pk_bf16((oc[it][4 * g + 0] - mu) * rstd * bf_lo(gw.x), (oc[it][4 * g + 1] - mu) * rstd * bf_hi(gw.x));
        ow.y = cvt_pk_bf16((oc[it][4 * g + 2] - mu) * rstd * bf_lo(gw.y), (oc[it][4 * g + 3] - mu) * rstd * bf_hi(gw.y));
        *(u32x2*)(AR + t * 4096 + e) = ow; }
    }
    STAGE();
  }
  __syncthreads();
#undef STAGE
#undef GLOAD
#undef RLOAD
}
}

__device__ __forceinline__ int src_in(int n) {
    if (n < 2048) { const int base = n & ~1023, r = n & 1023, hd = r >> 7, p = r & 127; return base + hd * 128 + (p >> 1) + 64 * (p & 1); }
    if (n < 7168) return n;
    if (n < 9216) return n + 64;
    if (n < 13312) return n + 64;
    if (n < 13376) { const int p = n - 13312; return 7168 + (p >> 1) + 32 * (p & 1); }
    return -1;
}
__device__ __forceinline__ int src_q(int n) {
    if (n < 2048) return (n >> 7) * 192 + (n & 127);
    const int r = n - 2048, hd = r >> 6, p = r & 63; return hd * 192 + 128 + (p >> 1) + 32 * (p & 1);
}
__device__ __forceinline__ int src_kv(int n) {
    if (n < 2048) return (n >> 7) * 256 + (n & 127);
    const int r = n - 2048; return (r >> 7) * 256 + 128 + (r & 127);
}

constexpr int CV_T_IN = (DINP / 64) * 32, CV_T_Q = (NQ / 64) * 8, CV_T_KV = (NKV / 64) * 8, CV_T_SQ = 32 * 32;
constexpr int CV_PER_LAYER = CV_T_IN + CV_T_Q + CV_T_KV + 3 * CV_T_SQ, CV_TOTAL = DEPTH * CV_PER_LAYER;

struct CvTile { const float* src; int nsrc; int scol; bf16_t* dst; const float* ksc; };
__device__ __forceinline__ void cv_decode(const Params& P, int tile, int nl, CvTile& c, int& dstride) {
    const int l = tile / CV_PER_LAYER; int r = tile % CV_PER_LAYER; unsigned char* ws = P.ws;
    if (r < CV_T_IN) { const int tn = r >> 5, tk = r & 31; c.nsrc = DIN; c.src = P.w_in + (size_t)l * DM * DIN + (size_t)tk * 64 * DIN; c.scol = src_in(tn * 64 + nl);
        dstride = DM; c.dst = (bf16_t*)(ws + WS_WT_IN + l * SZ_WT_IN) + (size_t)tn * 64 * DM + tk * 64; c.ksc = nullptr; return; }
    r -= CV_T_IN;
    if (r < CV_T_Q) { const int tn = r >> 3, tk = r & 7; c.nsrc = NQ; c.src = P.w_uq + (size_t)l * 512 * NQ + (size_t)tk * 64 * NQ; c.scol = src_q(tn * 64 + nl);
        dstride = 512; c.dst = (bf16_t*)(ws + WS_WT_Q + l * SZ_WT_Q) + (size_t)tn * 64 * 512 + tk * 64; c.ksc = P.g_cq + l * 512 + tk * 64; return; }
    r -= CV_T_Q;
    if (r < CV_T_KV) { const int tn = r >> 3, tk = r & 7; c.nsrc = NKV; c.src = P.w_ukv + (size_t)l * 512 * NKV + (size_t)tk * 64 * NKV; c.scol = src_kv(tn * 64 + nl);
        dstride = 512; c.dst = (bf16_t*)(ws + WS_WT_KV + l * SZ_WT_KV) + (size_t)tn * 64 * 512 + tk * 64; c.ksc = P.g_ckv + l * 512 + tk * 64; return; }
    r -= CV_T_KV;
    const int which = r / CV_T_SQ; r %= CV_T_SQ; const int tn = r >> 5, tk = r & 31;
    const size_t soff = (size_t)l * DM * DM + (size_t)tk * 64 * DM;
    c.nsrc = DM; c.scol = tn * 64 + nl; c.ksc = nullptr;
    if (which == 0) { c.src = P.w_ret + soff; dstride = 4096; c.dst = (bf16_t*)(ws + WS_WT_RM + l * SZ_WT_RM) + (size_t)tn * 64 * 4096 + tk * 64; return; }
    if (which == 1) { c.src = P.w_mla + soff; dstride = 4096; c.dst = (bf16_t*)(ws + WS_WT_RM + l * SZ_WT_RM) + (size_t)tn * 64 * 4096 + 2048 + tk * 64; return; }
    c.src = P.w_out + soff; dstride = DM; c.dst = (bf16_t*)(ws + WS_WT_O + l * SZ_WT_O) + (size_t)tn * 64 * DM + tk * 64;
}

__device__ __forceinline__ void phase_p0a(const Params& P, char* lds) {
    const int tid = tid_opaque(), G = gridDim.x, bid = blockIdx.x;
    if (bid == 0 && tid < 64) ((unsigned*)(P.ws + WS_CTR))[tid] = 0u;
    float* cosr = (float*)(P.ws + WS_COSR); float* sinr = (float*)(P.ws + WS_SINR); float* cosm = (float*)(P.ws + WS_COSM); float* sinm = (float*)(P.ws + WS_SINM);
    for (int i = bid * NTHREADS + tid; i < T_TOK * 96; i += G * NTHREADS) {
        const int t = i / 96, j = i % 96; const float pos = (float)P.pos[t];
        const int jj = j < 64 ? j : j - 64; const float inv = j < 64 ? P.inv_r[jj] : P.inv_m[jj]; const float a = pos * inv;
        const float kf = rintf(a * 0.15915494309189535f); float r = fmaf(-kf, 6.28125f, a); r = fmaf(-kf, 0.0019354820251464844f, r); r = fmaf(-kf, -1.7484555314695172e-07f, r);
        const float rf = r * 0.15915494309189535f; const float cv = __builtin_amdgcn_cosf(rf), sv = __builtin_amdgcn_sinf(rf);
        if (j < 64) { cosr[t * 64 + jj] = cv; sinr[t * 64 + jj] = sv; } else { cosm[t * 32 + jj] = cv; sinm[t * 32 + jj] = sv; }
    }
    {
        float* cact = (float*)lds; float* part = (float*)(lds + 32768);
        for (int i = tid; i < 4 * 2048; i += NTHREADS) cact[i] = silu_f(P.c[i]);
        __syncthreads();
        float* mod = (float*)(P.ws + WS_MOD);
        const int cn = tid & 63, ks = tid >> 6;
        for (int item = bid; item < DEPTH * 96; item += G) {
            const int l = item / 96, n0 = (item % 96) * 64;
            const float* wp = P.w_mod + ((size_t)l * DM + ks * 256) * 6144 + n0 + cn;
            float a0 = 0.f, a1 = 0.f, a2 = 0.f, a3 = 0.f;
#pragma unroll 8
            for (int k = 0; k < 256; ++k) { const float w = wp[(size_t)k * 6144]; const int kk = ks * 256 + k; a0 += cact[kk] * w; a1 += cact[2048 + kk] * w; a2 += cact[4096 + kk] * w; a3 += cact[6144 + kk] * w; }
            *(f32x4*)(part + (ks * 64 + cn) * 4) = (f32x4){a0, a1, a2, a3};
            __syncthreads();
            if (tid < 256) { const int c2 = tid & 63, b = tid >> 6; float s = P.b_mod[l * 6144 + n0 + c2];
#pragma unroll
                for (int q = 0; q < 8; ++q) s += part[(q * 64 + c2) * 4 + b];
                mod[((size_t)l * 4 + b) * 6144 + n0 + c2] = s; }
            __syncthreads();
        }
    }
    {
        float* tl = (float*)lds;
        const int nl = tid & 63, kr = tid >> 6;
        float v[8]; CvTile c; int dstride = 0;
        int tile = bid;
        if (tile < CV_TOTAL) { cv_decode(P, tile, nl, c, dstride);
#pragma unroll
            for (int i = 0; i < 8; ++i) v[i] = c.scol >= 0 ? c.src[(size_t)(kr + 8 * i) * c.nsrc + c.scol] : 0.f; }
        while (tile < CV_TOTAL) {
#pragma unroll
            for (int i = 0; i < 8; ++i) tl[(kr + 8 * i) * 65 + nl] = v[i];
            __syncthreads();
            bf16_t* dst = c.dst; const int ds = dstride; const float sc = c.ksc ? c.ksc[nl] : 1.0f;
            const int nxt = tile + G;
            if (nxt < CV_TOTAL) { cv_decode(P, nxt, nl, c, dstride);
#pragma unroll
                for (int i = 0; i < 8; ++i) v[i] = c.scol >= 0 ? c.src[(size_t)(kr + 8 * i) * c.nsrc + c.scol] : 0.f; }
#pragma unroll
            for (int i = 0; i < 8; ++i) { const int nn = kr + 8 * i; dst[(size_t)nn * ds + nl] = f2bf(tl[nl * 65 + nn] * sc); }
            __syncthreads();
            tile = nxt;
        }
    }
}

__device__ __forceinline__ void phase_p0b(const Params& P) {
    const int tid = tid_opaque(), lane = tid & 63, gw = blockIdx.x * 8 + (tid >> 6), GW = gridDim.x * 8;
    const float* mod = (const float*)(P.ws + WS_MOD);
    bf16_t* XG = (bf16_t*)(P.ws + WS_XG); float* ssqx = (float*)(P.ws + WS_SSQX);
    for (int row = gw; row < T_TOK; row += GW) {
        const int b = row >> 12; float ss = 0.f;
#pragma unroll
        for (int i = 0; i < 8; ++i) { const int col = (i * 64 + lane) * 4; const f32x4 x = *(const f32x4*)(P.x + (size_t)row * DM + col);
            const f32x4 g = *(const f32x4*)(P.g_norm + col), s = *(const f32x4*)(mod + (size_t)b * 6144 + 2048 + col); const f32x4 y = x * g * (s + 1.0f);
            ss += (x[0] * x[0] + x[1] * x[1]) + (x[2] * x[2] + x[3] * x[3]);
            u32x2 w; w.x = cvt_pk_bf16(y[0], y[1]); w.y = cvt_pk_bf16(y[2], y[3]); *(u32x2*)(XG + (size_t)row * DM + col) = w; }
#pragma unroll
        for (int o = 32; o >= 1; o >>= 1) ss += __shfl_xor(ss, o);
        if (lane < 32) ssqx[(size_t)row * 32 + lane] = lane == 0 ? ss : 0.f;
    }
    float* bias2 = (float*)(P.ws + WS_BIAS2);
    for (int r = gw; r < DEPTH * DINP; r += GW) {
        const int l = r / DINP, n = r % DINP;
        const bf16_t* wrow = (const bf16_t*)(P.ws + WS_WT_IN + l * SZ_WT_IN) + (size_t)n * DM;
        float a[4] = {0.f, 0.f, 0.f, 0.f};
#pragma unroll
        for (int i = 0; i < 4; ++i) { const int k = (i * 64 + lane) * 8; const u32x4 w = *(const u32x4*)(wrow + k);
            const float wf[8] = {bf_lo(w.x), bf_hi(w.x), bf_lo(w.y), bf_hi(w.y), bf_lo(w.z), bf_hi(w.z), bf_lo(w.w), bf_hi(w.w)};
#pragma unroll
            for (int b = 0; b < 4; ++b) { const float* sp = mod + ((size_t)l * 4 + b) * 6144 + k; const f32x4 s0 = *(const f32x4*)sp, s1 = *(const f32x4*)(sp + 4);
                a[b] += (wf[0] * s0[0] + wf[1] * s0[1]) + (wf[2] * s0[2] + wf[3] * s0[3]) + (wf[4] * s1[0] + wf[5] * s1[1]) + (wf[6] * s1[2] + wf[7] * s1[3]); } }
#pragma unroll
        for (int b = 0; b < 4; ++b) {
#pragma unroll
            for (int o = 32; o >= 1; o >>= 1) a[b] += __shfl_xor(a[b], o); }
        if (lane < 4) bias2[((size_t)l * 4 + lane) * DINP + n] = lane == 0 ? a[0] : lane == 1 ? a[1] : lane == 2 ? a[2] : a[3];
    }
}

__device__ __forceinline__ void phase_final(const Params& P) {
    const int tid = tid_opaque(), lane = tid & 63, gw = blockIdx.x * 8 + (tid >> 6), GW = gridDim.x * 8;
    const float* ssqx = (const float*)(P.ws + WS_SSQX);
    for (int row = gw; row < T_TOK; row += GW) {
        float ss = lane < 32 ? ssqx[(size_t)row * 32 + lane] : 0.f;
#pragma unroll
        for (int o = 32; o >= 1; o >>= 1) ss += __shfl_xor(ss, o);
        const float rinv = rsqrtf(ss * (1.0f / 2048.0f) + EPS);
#pragma unroll
        for (int i = 0; i < 8; ++i) { const int col = (i * 64 + lane) * 4; float* p = P.out + (size_t)row * DM + col; const f32x4 x = *(const f32x4*)p; const f32x4 g = *(const f32x4*)(P.g_final + col);
            *(f32x4*)p = x * rinv * g; }
    }
}

constexpr int N_PHASES = 2 + 5 * DEPTH + 1;

template <int S_>
__device__ __forceinline__ void layer_phase(const Params& P, int l, unsigned char* lds_raw) {
    __attribute__((address_space(1))) unsigned char* wsg = (__attribute__((address_space(1))) unsigned char*)P.ws; asm volatile("" : "+s"(wsg)); unsigned char* ws = (unsigned char*)wsg;
    char* lds = (char*)lds_raw; PG8_LAS unsigned char* lds3 = (PG8_LAS unsigned char*)lds_raw;
    const int G = gridDim.x; int bid = blockIdx.x; asm volatile("" : "+s"(bid));
    float* ssqx = (float*)(ws + WS_SSQX); float* ssqc = (float*)(ws + WS_SSQC);
    const float* cosr = (const float*)(ws + WS_COSR); const float* sinr = (const float*)(ws + WS_SINR); const float* cosm = (const float*)(ws + WS_COSM); const float* sinm = (const float*)(ws + WS_SINM);
    bf16_t* XG = (bf16_t*)(ws + WS_XG); bf16_t* RQ = (bf16_t*)(ws + WS_RQ); bf16_t* RK = (bf16_t*)(ws + WS_RK); bf16_t* RV = (bf16_t*)(ws + WS_RV); bf16_t* SRG = (bf16_t*)(ws + WS_SRG); bf16_t* SMG = (bf16_t*)(ws + WS_SMG);
    bf16_t* CQ = (bf16_t*)(ws + WS_CQ); bf16_t* CKV = (bf16_t*)(ws + WS_CKV); bf16_t* GATE = (bf16_t*)(ws + WS_GATE); bf16_t* QB = (bf16_t*)(ws + WS_QB); bf16_t* KB = (bf16_t*)(ws + WS_KB); bf16_t* VB = (bf16_t*)(ws + WS_VB);
    bf16_t* AR = (bf16_t*)(ws + WS_AR); bf16_t* MERGED = (bf16_t*)(ws + WS_MERGED);
    const float* mod = (const float*)(ws + WS_MOD);
    if constexpr (S_ == 0) {
        pg8::Gemm g{XG, (const bf16_t*)(ws + WS_WT_IN + l * SZ_WT_IN), T_TOK, DINP, DM}; pg8::StaticOrder S; S.init(T_TOK, DINP, G, bid);
        EpiIn E{ssqx, (const float*)(ws + WS_BIAS2) + (size_t)l * 4 * DINP, cosr, sinr, cosm, sinm, RQ, RK, RV, SRG, CQ, CKV, SMG, GATE, KB, ssqc};
        pg8::gemm_phase<EpiIn, pg8::StaticOrder>(lds3, g, S, E);
    } else if constexpr (S_ == 1) {
        { pg8::Gemm g{CQ, (const bf16_t*)(ws + WS_WT_Q + l * SZ_WT_Q), T_TOK, NQ, 512}; pg8::StaticOrder S; S.init(T_TOK, NQ, G, bid);
          EpiUp<0> E{ssqc, cosm, sinm, QB, KB, VB}; pg8::gemm_phase<EpiUp<0>, pg8::StaticOrder>(lds3, g, S, E); }
        { pg8::Gemm g{CKV, (const bf16_t*)(ws + WS_WT_KV + l * SZ_WT_KV), T_TOK, NKV, 512}; pg8::StaticOrder S; S.init(T_TOK, NKV, G, bid);
          EpiUp<1> E{ssqc, cosm, sinm, QB, KB, VB}; pg8::gemm_phase<EpiUp<1>, pg8::StaticOrder>(lds3, g, S, E); }
    } else if constexpr (S_ == 2) {
#if defined(SKIP_RET)
        for (size_t i = (size_t)bid * NTHREADS + threadIdx.x; i < (size_t)T_TOK * 256; i += (size_t)G * NTHREADS) { const size_t t = i >> 8, c = (i & 255) * 8; *(u32x4*)(AR + t * 4096 + c) = *(const u32x4*)(SRG + t * 2048 + c); }
#else
        if (bid < 32 && P.ph_hi != 77) ret::worker(RQ, RK, RV, SRG, AR, bid >> 3, bid & 7, lds);
#endif
#if defined(SKIP_ATT)
        for (size_t i = (size_t)bid * NTHREADS + threadIdx.x; i < (size_t)T_TOK * 256; i += (size_t)G * NTHREADS) { const size_t t = i >> 8, c = (i & 255) * 8; *(u32x4*)(AR + t * 4096 + 2048 + c) = *(const u32x4*)(SMG + t * 2048 + c); }
        if (false)
#endif
        {
            unsigned* ctr = (unsigned*)(ws + WS_CTR) + l; PG8_LAS unsigned* slot = (PG8_LAS unsigned*)(lds_raw + LDS_BYTES - 16);
            for (;;) {
                if (threadIdx.x == 0) *slot = __hip_atomic_fetch_add(ctr, 1u, __ATOMIC_RELAXED, __HIP_MEMORY_SCOPE_AGENT);
                __syncthreads();
                const int it = (int)*slot;
                __syncthreads();
                if (it >= 1024) break;
                const int qb = 15 - (it >> 6), bh = it & 63, b = bh >> 4, h = bh & 15;
                const size_t row0 = (size_t)b * SEQ + qb * 256;
                att::attn_item(QB + row0 * 3072 + h * 192, KB + (size_t)b * SEQ * 3072 + h * 192, VB + (size_t)b * SEQ * 2048 + h * 128, AR + row0 * 4096 + 2048 + h * 128, SMG + row0 * 2048 + h * 128, qb, lds);
            }
        }
    } else if constexpr (S_ == 3) {
        pg8::Gemm g{AR, (const bf16_t*)(ws + WS_WT_RM + l * SZ_WT_RM), T_TOK, DM, 4096}; pg8::StaticOrder S; S.init(T_TOK, DM, G, bid);
        EpiMerge E{GATE, MERGED}; pg8::gemm_phase<EpiMerge, pg8::StaticOrder>(lds3, g, S, E);
    } else {
        pg8::Gemm g{MERGED, (const bf16_t*)(ws + WS_WT_O + l * SZ_WT_O), T_TOK, DM, DM}; pg8::StaticOrder S; S.init(T_TOK, DM, G, bid);
        const bool lastl = (l == DEPTH - 1);
        const int ln = lastl ? 0 : l + 1;
        EpiOut E{l == 0 ? P.x : P.out, P.out, mod + (size_t)l * 4 * 6144 + 4096, P.g_norm + ln * DM, mod + (size_t)ln * 4 * 6144 + 2048, lastl ? (bf16_t*)nullptr : XG, ssqx};
        pg8::gemm_phase<EpiOut, pg8::StaticOrder>(lds3, g, S, E);
    }
}

__device__ __forceinline__ void run_phase(const Params& P, int ph, unsigned char* lds_raw) {
    if (ph == 0) { phase_p0a(P, (char*)lds_raw); return; }
    if (ph == 1) { phase_p0b(P); return; }
    if (ph == N_PHASES - 1) { phase_final(P); return; }
    const int l = (ph - 2) / 5, s = (ph - 2) % 5;
    if (s == 0) layer_phase<0>(P, l, lds_raw);
    else if (s == 1) layer_phase<1>(P, l, lds_raw);
    else if (s == 2) layer_phase<2>(P, l, lds_raw);
    else if (s == 3) layer_phase<3>(P, l, lds_raw);
    else layer_phase<4>(P, l, lds_raw);
}


#define XB_TMO      128
#define XB_XCNT(j)  (256  + 64 * (j))
#define XB_XSUB(j)  (1280 + 64 * (j))
#define XB_XGEN(j)  (2304 + 64 * (j))
#define XB_TOP      3328
#define XB_TOPGEN   3392
#define XCD_BAR_WORDS 3456
#define XB_SPIN_CAP (1u << 18)
__device__ __forceinline__ unsigned xb_ld(unsigned* p)              { return __hip_atomic_load(p, __ATOMIC_RELAXED, __HIP_MEMORY_SCOPE_AGENT); }
__device__ __forceinline__ unsigned xb_add(unsigned* p, unsigned v) { return __hip_atomic_fetch_add(p, v, __ATOMIC_RELAXED, __HIP_MEMORY_SCOPE_AGENT); }
__device__ __forceinline__ unsigned xb_xcc_id() { return (unsigned)__builtin_amdgcn_s_getreg((3 << 11) | 20) & 0xFu; }
#define XB_SPIN(cond, bar) do { unsigned _sp = 0; while (cond) { __builtin_amdgcn_s_sleep(1); \
    if ((++_sp & 255u) == 0u) { if (xb_ld(&(bar)[XB_TMO])) break; if (_sp > XB_SPIN_CAP) { atomicAdd(&(bar)[XB_TMO], 1u); break; } } } } while (0)
struct XcdBarrier { unsigned* bar; unsigned x; volatile PG8_LAS unsigned* st; };
__device__ __forceinline__ void xcd_barrier_complete(unsigned* bar, unsigned x, unsigned& nloc, unsigned& nx) {
    const unsigned G = gridDim.x * gridDim.y * gridDim.z;
    unsigned sum, cnt, mine, sp = 0u;
    for (;;) {
        sum = 0u; cnt = 0u; mine = 0u;
#pragma unroll
        for (unsigned j = 0; j < 16; ++j) { const unsigned c = xb_ld(&bar[XB_XCNT(j)]); sum += c; cnt += (c > 0u) ? 1u : 0u; mine = (j == x) ? c : mine; }
        if (sum == G) break;
        __builtin_amdgcn_s_sleep(1);
        if ((++sp & 255u) == 0u) { if (xb_ld(&bar[XB_TMO])) break; if (sp > XB_SPIN_CAP) { atomicAdd(&bar[XB_TMO], 1u); break; } }
    }
    nloc = mine > 0u ? mine : 1u; nx = cnt > 0u ? cnt : 1u;
}
__device__ __forceinline__ void xcd_barrier(const XcdBarrier& b) {
    asm volatile("s_waitcnt vmcnt(0)" ::: "memory");
    __syncthreads();
    if (threadIdx.x == 0) {
        unsigned* bar = b.bar;
        __builtin_amdgcn_s_waitcnt(0);
        unsigned nloc = b.st[0], nx = b.st[1];
        if (nloc == 0u) { xcd_barrier_complete(bar, b.x, nloc, nx); b.st[0] = nloc; b.st[1] = nx; }
        const unsigned old = xb_add(&bar[XB_XSUB(b.x)], 1u);
        const unsigned gen = old / nloc;
        if (old + 1u == (gen + 1u) * nloc) {
            __builtin_amdgcn_fence(__ATOMIC_RELEASE, "agent");
            asm volatile("s_waitcnt vmcnt(0)" ::: "memory");
            const unsigned og = xb_add(&bar[XB_TOP], 1u);
            const unsigned tg = og / nx;
            if (og + 1u == (tg + 1u) * nx) xb_add(&bar[XB_TOPGEN], 1u);
            else XB_SPIN(xb_ld(&bar[XB_TOPGEN]) == tg, bar);
            __builtin_amdgcn_fence(__ATOMIC_ACQUIRE, "agent");
            xb_add(&bar[XB_XGEN(b.x)], 1u);
            asm volatile("s_waitcnt vmcnt(0)" ::: "memory");
        } else {
            XB_SPIN(xb_ld(&bar[XB_XGEN(b.x)]) == gen, bar);
            __builtin_amdgcn_fence(__ATOMIC_ACQUIRE, "agent");
            asm volatile("s_waitcnt vmcnt(0)" ::: "memory");
        }
    }
    __syncthreads();
}

#if MK_COOP
__global__ void __launch_bounds__(NTHREADS) hybrid_fwd(Params P) {
    extern __shared__ __attribute__((aligned(16))) unsigned char lds_raw[];
#if defined(MK_PROBE)
    if (blockIdx.x == 0 && threadIdx.x == 0) { unsigned long long* tm = (unsigned long long*)(P.ws + WS_END); for (int i = 0; i < 16; ++i) tm[i] = 0; tm[16] = wall_clock64(); }
#endif
    { volatile PG8_LAS unsigned* st = (volatile PG8_LAS unsigned*)(PG8_LAS unsigned char*)(lds_raw + LDS_GEMM);
      if (threadIdx.x < 2) st[threadIdx.x] = 0u;
      __syncthreads();
      if (threadIdx.x == 0) (void)xb_add(&((unsigned*)(P.ws + WS_XBAR))[XB_XCNT(xb_xcc_id())], 1u); }
    for (int ph = P.ph_lo; ph < P.ph_hi; ++ph) {
        if (ph == P.ph_lo + 1) cg::this_grid().sync();
        else if (ph > P.ph_lo) { XcdBarrier xb_; xb_.bar = (unsigned*)(P.ws + WS_XBAR); xb_.x = xb_xcc_id(); xb_.st = (volatile PG8_LAS unsigned*)(PG8_LAS unsigned char*)(lds_raw + LDS_GEMM); xcd_barrier(xb_); }
        run_phase(P, ph, lds_raw);
#if defined(MK_REPEAT)
        { const int kind = ph == 0 ? 0 : (ph == 1 ? 1 : (ph == N_PHASES - 1 ? 7 : 2 + (ph - 2) % 5)); if (kind == MK_REPEAT) { cg::this_grid().sync(); if (kind == 4 && blockIdx.x == 0 && threadIdx.x == 0) ((unsigned*)(P.ws + WS_CTR))[(ph - 2) / 5] = 0u; cg::this_grid().sync(); run_phase(P, ph, lds_raw); } }
#endif
#if defined(MK_PROBE)
        cg::this_grid().sync();
        if (blockIdx.x == 0 && threadIdx.x == 0) { unsigned long long* tm = (unsigned long long*)(P.ws + WS_END); const unsigned long long t = wall_clock64();
            const int kind = ph == 0 ? 0 : (ph == 1 ? 1 : (ph == N_PHASES - 1 ? 7 : 2 + (ph - 2) % 5)); tm[kind] += t - tm[16]; tm[16] = t; }
#endif
    }
#if defined(MK_PROBE)
    cg::this_grid().sync();
    if (blockIdx.x == 0) { const unsigned long long* tm = (const unsigned long long*)(P.ws + WS_END); const float ua = (float)tm[MK_PROBE_A] * 0.01f, ub = (float)tm[MK_PROBE_B] * 0.01f; int n = (int)(ub / 50.f) + 1; if (n > 99) n = 99;
        for (int i = threadIdx.x; i < n; i += NTHREADS) P.out[i] = 10.f * ua; }
#endif
}
#else
__global__ void __launch_bounds__(NTHREADS) k_p0a(Params P) { extern __shared__ __attribute__((aligned(16))) unsigned char lds_raw[]; phase_p0a(P, (char*)lds_raw); }
__global__ void __launch_bounds__(NTHREADS) k_p0b(Params P) { phase_p0b(P); }
__global__ void __launch_bounds__(NTHREADS) k_final(Params P) { phase_final(P); }
template <int S_> __global__ void __launch_bounds__(NTHREADS) k_layer(Params P) { extern __shared__ __attribute__((aligned(16))) unsigned char lds_raw[]; layer_phase<S_>(P, P.ph_lo, lds_raw); }
#endif

#if defined(MK_PROBE) && !MK_COOP
__global__ void k_stamp(Params P, int kind) { unsigned long long* tm = (unsigned long long*)(P.ws + WS_END); const unsigned long long t = wall_clock64();
    if (kind < 0) { for (int i = 0; i < 16; ++i) tm[i] = 0; } else tm[kind] += t - tm[16]; tm[16] = t; }
__global__ void k_probe_report(Params P) { const unsigned long long* tm = (const unsigned long long*)(P.ws + WS_END); const float ua = (float)tm[MK_PROBE_A] * 0.01f, ub = (float)tm[MK_PROBE_B] * 0.01f; int n = (int)(ub / 50.f) + 1; if (n > 99) n = 99;
    for (int i = threadIdx.x; i < n; i += blockDim.x) P.out[i] = 10.f * ua; }
#define STAMP(k) hipLaunchKernelGGL(k_stamp, dim3(1), dim3(1), 0, stream, p, (k))
#else
#define STAMP(k) do { } while (0)
#endif

extern "C" void kernel_launch(void* const* d_in, const int* in_sizes, int n_in, void* d_out, int out_size, void* d_ws, size_t ws_size, hipStream_t stream) {
    static int grid = 0;
    if (grid == 0) {
        if (n_in != 15 || out_size != T_TOK * DM || ws_size < WS_TOTAL) { fprintf(stderr, "kernel_launch: unexpected shapes (n_in %d, out %d, ws %zu < %zu)\n", n_in, out_size, ws_size, (size_t)WS_TOTAL); grid = -1; return; }
        int dev = 0, cus = 0; bool ok = true;
        ok = ok && hipGetDevice(&dev) == hipSuccess; ok = ok && hipDeviceGetAttribute(&cus, hipDeviceAttributeMultiprocessorCount, dev) == hipSuccess;
#if MK_COOP
        int per_cu = 0;
        ok = ok && hipFuncSetAttribute((const void*)hybrid_fwd, hipFuncAttributeMaxDynamicSharedMemorySize, LDS_BYTES) == hipSuccess;
        if (hipOccupancyMaxActiveBlocksPerMultiprocessor(&per_cu, (const void*)hybrid_fwd, NTHREADS, LDS_BYTES) != hipSuccess || per_cu < 1) { fprintf(stderr, "kernel_launch: occupancy query says %d blocks per CU\n", per_cu); }
        (void)hipGetLastError();
#else
        ok = ok && hipFuncSetAttribute((const void*)k_p0a, hipFuncAttributeMaxDynamicSharedMemorySize, LDS_BYTES) == hipSuccess;
        ok = ok && hipFuncSetAttribute((const void*)k_layer<0>, hipFuncAttributeMaxDynamicSharedMemorySize, LDS_BYTES) == hipSuccess;
        ok = ok && hipFuncSetAttribute((const void*)k_layer<1>, hipFuncAttributeMaxDynamicSharedMemorySize, LDS_BYTES) == hipSuccess;
        ok = ok && hipFuncSetAttribute((const void*)k_layer<2>, hipFuncAttributeMaxDynamicSharedMemorySize, LDS_BYTES) == hipSuccess;
        ok = ok && hipFuncSetAttribute((const void*)k_layer<3>, hipFuncAttributeMaxDynamicSharedMemorySize, LDS_BYTES) == hipSuccess;
        ok = ok && hipFuncSetAttribute((const void*)k_layer<4>, hipFuncAttributeMaxDynamicSharedMemorySize, LDS_BYTES) == hipSuccess;
#endif
        if (!ok || cus < 1) { fprintf(stderr, "kernel_launch: device set-up failed\n"); grid = -1; return; }
        grid = cus;
    }
    if (grid < 0) return;
    Params p{};
    p.x = (const float*)d_in[0]; p.c = (const float*)d_in[1]; p.pos = (const int*)d_in[2]; p.w_mod = (const float*)d_in[3]; p.b_mod = (const float*)d_in[4]; p.g_norm = (const float*)d_in[5];
    p.w_in = (const float*)d_in[6]; p.g_cq = (const float*)d_in[7]; p.g_ckv = (const float*)d_in[8]; p.w_uq = (const float*)d_in[9]; p.w_ukv = (const float*)d_in[10];
    p.w_ret = (const float*)d_in[11]; p.w_mla = (const float*)d_in[12]; p.w_out = (const float*)d_in[13]; p.g_final = (const float*)d_in[14];
    p.out = (float*)d_out; p.ws = (unsigned char*)d_ws;
    for (int j = 0; j < 64; ++j) p.inv_r[j] = (float)(1.0 / pow(10000.0, (double)(2 * j) / 128.0));
    for (int j = 0; j < 32; ++j) p.inv_m[j] = (float)(1.0 / pow(10000.0, (double)(2 * j) / 64.0));
#if MK_COOP
    p.ph_lo = 0; p.ph_hi = N_PHASES;
    if (hipMemsetAsync((char*)d_ws + WS_XBAR, 0, XCD_BAR_WORDS * 4, stream) != hipSuccess) { fprintf(stderr, "kernel_launch: memset of the barrier words failed\n"); return; }
    void* args[] = {&p};
    hipError_t e = hipLaunchCooperativeKernel((const void*)hybrid_fwd, dim3(grid), dim3(NTHREADS), args, LDS_BYTES, stream);
    if (e != hipSuccess) fprintf(stderr, "kernel_launch: cooperative launch failed: %s (grid %d)\n", hipGetErrorString(e), grid);
#else
    p.ph_lo = 0; p.ph_hi = 0;
    STAMP(-1);
    hipLaunchKernelGGL(k_p0a, dim3(grid), dim3(NTHREADS), LDS_BYTES, stream, p); STAMP(0);
#if defined(MK_REPEAT)
    if (MK_REPEAT == 0) hipLaunchKernelGGL(k_p0a, dim3(grid), dim3(NTHREADS), LDS_BYTES, stream, p);
#endif
    hipLaunchKernelGGL(k_p0b, dim3(grid), dim3(NTHREADS), 0, stream, p); STAMP(1);
    for (int l = 0; l < DEPTH; ++l) { p.ph_lo = l;
        hipLaunchKernelGGL(k_layer<0>, dim3(grid), dim3(NTHREADS), LDS_BYTES, stream, p); STAMP(2);
        hipLaunchKernelGGL(k_layer<1>, dim3(grid), dim3(NTHREADS), LDS_BYTES, stream, p); STAMP(3);
        hipLaunchKernelGGL(k_layer<2>, dim3(grid), dim3(NTHREADS), LDS_BYTES, stream, p); STAMP(4);
#if defined(MK_REPEAT)
        if (MK_REPEAT == 4) { (void)hipMemsetAsync((char*)d_ws + WS_CTR, 0, 256, stream); hipLaunchKernelGGL(k_layer<2>, dim3(grid), dim3(NTHREADS), LDS_BYTES, stream, p); }
        if (MK_REPEAT == 44) { (void)hipMemsetAsync((char*)d_ws + WS_CTR, 0, 256, stream); p.ph_hi = 77; hipLaunchKernelGGL(k_layer<2>, dim3(grid), dim3(NTHREADS), LDS_BYTES, stream, p); p.ph_hi = 0; }
        if (MK_REPEAT == 2) hipLaunchKernelGGL(k_layer<0>, dim3(grid), dim3(NTHREADS), LDS_BYTES, stream, p);
        if (MK_REPEAT == 3) hipLaunchKernelGGL(k_layer<1>, dim3(grid), dim3(NTHREADS), LDS_BYTES, stream, p);
#endif
        hipLaunchKernelGGL(k_layer<3>, dim3(grid), dim3(NTHREADS), LDS_BYTES, stream, p); STAMP(5);
#if defined(MK_REPEAT)
        if (MK_REPEAT == 5) hipLaunchKernelGGL(k_layer<3>, dim3(grid), dim3(NTHREADS), LDS_BYTES, stream, p);
#endif
        hipLaunchKernelGGL(k_layer<4>, dim3(grid), dim3(NTHREADS), LDS_BYTES, stream, p); STAMP(6); }
    hipLaunchKernelGGL(k_final, dim3(grid), dim3(NTHREADS), 0, stream, p); STAMP(7);
#if defined(MK_PROBE)
    hipLaunchKernelGGL(k_probe_report, dim3(1), dim3(128), 0, stream, p);
#endif
#endif
}
```
